# Optimizing an MI355X kernel written in HIP

```python
import math
import jax, jax.numpy as jnp
from jax import lax
import numpy as np

D_MODEL = 1024
BATCH = 2
SEQ = 8192
DEPTH = 2

DN_ALPHA = (2 * DEPTH) ** 0.25
DN_BETA = (8 * DEPTH) ** -0.25
LN_EPS = 1e-5

SSD_HEAD_DIM = 64
SSD_INNER = D_MODEL
SSD_HEADS = SSD_INNER // SSD_HEAD_DIM
SSD_GROUPS = 2
SSD_STATE = 128
SSD_CONV = 4
SSD_CHUNK = 128

GLA_HEADS = 4
GLA_KEY = D_MODEL // 2
GLA_VAL = D_MODEL
GLA_DK = GLA_KEY // GLA_HEADS
GLA_DV = GLA_VAL // GLA_HEADS
GLA_RANK = 16
GLA_TAU = 16.0
GLA_CHUNK = 64

MIX_WIDTH = SSD_INNER + GLA_VAL

IN_SPLITS = (SSD_INNER, SSD_INNER, SSD_GROUPS * SSD_STATE, SSD_GROUPS * SSD_STATE, SSD_HEADS,
             GLA_KEY, GLA_KEY, GLA_VAL, GLA_VAL, GLA_RANK)
IN_WIDTH = sum(IN_SPLITS)
IN_OFFSETS = tuple(int(o) for o in np.cumsum(IN_SPLITS)[:-1])
CONV_CH = SSD_INNER + 2 * SSD_GROUPS * SSD_STATE

S5_GROUP = 16
S5_GROUPS = D_MODEL // S5_GROUP
S5_STATE = 64

FFN_HIDDEN = -(-8 * D_MODEL // (3 * 256)) * 256

kernel_name = "hybrid_ssd_gla_s5_deepnorm"


def layer_norm(x, g, b):
    xf = x.astype(jnp.float32)
    mu = jnp.mean(xf, axis=-1, keepdims=True)
    var = jnp.mean(jnp.square(xf - mu), axis=-1, keepdims=True)
    return ((xf - mu) * lax.rsqrt(var + LN_EPS) * g + b).astype(x.dtype)


def rms_norm(x, g):
    xf = x.astype(jnp.float32)
    return (xf * lax.rsqrt(jnp.mean(jnp.square(xf), axis=-1, keepdims=True) + LN_EPS) * g).astype(x.dtype)


def causal_depthwise_conv(x, w, b):
    width, c = w.shape
    y = lax.conv_general_dilated(x, w[:, None, :], window_strides=(1,), padding=[(width - 1, 0)],
                                 dimension_numbers=('NWC', 'WIO', 'NWC'), feature_group_count=c)
    return y + b


def ssd_chunked(x, dt, A, Bm, Cm, D_skip):
    b, l, h, p = x.shape
    g, n = Bm.shape[2], Bm.shape[3]
    e = h // g
    q = SSD_CHUNK
    nc = l // q
    x_c = x.reshape(b, nc, q, g, e, p)
    dt_c = dt.reshape(b, nc, q, g, e)
    B_c = Bm.reshape(b, nc, q, g, n)
    C_c = Cm.reshape(b, nc, q, g, n)
    dA_cum = jnp.cumsum(dt_c * A.reshape(g, e), axis=2)
    causal = jnp.tril(jnp.ones((q, q), bool))[:, :, None, None]
    seg = dA_cum[:, :, :, None] - dA_cum[:, :, None, :]
    decay = jnp.exp(jnp.where(causal, seg, -jnp.inf))
    scores = jnp.einsum('bcign,bcjgn->bcijg', C_c, B_c)
    w = scores[..., None] * decay * dt_c[:, :, None]
    y_diag = jnp.einsum('bcijge,bcjgep->bcigep', w, x_c)
    decay_to_end = jnp.exp(dA_cum[:, :, -1:] - dA_cum)
    xw = x_c * (decay_to_end * dt_c)[..., None]
    states = jnp.einsum('bcjgn,bcjgep->bcgepn', B_c, xw)
    chunk_decay = jnp.exp(dA_cum[:, :, -1])

    def step(h_prev, inp):
        dec, st = inp
        return dec[..., None, None] * h_prev + st, h_prev

    h0 = jnp.zeros((b, g, e, p, n), states.dtype)
    _, h_enter = lax.scan(step, h0, (jnp.moveaxis(chunk_decay, 1, 0), jnp.moveaxis(states, 1, 0)))
    h_enter = jnp.moveaxis(h_enter, 0, 1)
    y_off = jnp.einsum('bcign,bcgepn->bcigep', C_c, h_enter) * jnp.exp(dA_cum)[..., None]
    y = y_diag + y_off + D_skip.reshape(g, e)[:, :, None] * x_c
    return y.reshape(b, l, h, p)


def gla_chunked(q, k, v, log_a):
    b, l, h, dk = q.shape
    dv = v.shape[-1]
    c = GLA_CHUNK
    nc = l // c
    causal = jnp.tril(jnp.ones((c, c), bool))[None, :, :, None, None]

    def to_chunks(t):
        return jnp.moveaxis(t.reshape(b, nc, c, h, t.shape[-1]), 1, 0)

    def step(S, inp):
        qc, kc, vc, gc = inp
        G = jnp.cumsum(gc, axis=1)
        rel = jnp.where(causal, G[:, :, None] - G[:, None], -jnp.inf)
        attn = jnp.einsum('bihd,bjhd,bijhd->bhij', qc, kc, jnp.exp(rel))
        o_intra = jnp.einsum('bhij,bjhv->bihv', attn, vc)
        o_inter = jnp.einsum('bihd,bhdv->bihv', qc * jnp.exp(G), S)
        G_last = G[:, -1]
        k_dec = kc * jnp.exp(G_last[:, None] - G)
        S_new = jnp.exp(G_last)[..., None] * S + jnp.einsum('bjhd,bjhv->bhdv', k_dec, vc)
        return S_new, o_intra + o_inter

    S0 = jnp.zeros((b, h, dk, dv), jnp.float32)
    _, o = lax.scan(step, S0, (to_chunks(q), to_chunks(k), to_chunks(v), to_chunks(log_a)))
    return jnp.moveaxis(o, 0, 1).reshape(b, l, h, dv)


def ssd_gla_mixer(x, w_in, conv_w, conv_b, dt_bias, A_log, D_skip, ssd_norm,
                  gla_w_gate, gla_b_gate, gla_norm, w_out):
    b, l, _ = x.shape
    proj = x @ w_in
    z, xs, Bs, Cs, dt_raw, gq, gk, gv, gr, ga = jnp.split(proj, IN_OFFSETS, axis=-1)
    xbc = jax.nn.silu(causal_depthwise_conv(jnp.concatenate([xs, Bs, Cs], axis=-1), conv_w, conv_b))
    xs, Bs, Cs = jnp.split(xbc, (SSD_INNER, SSD_INNER + SSD_GROUPS * SSD_STATE), axis=-1)
    dt = jax.nn.softplus((dt_raw + dt_bias).astype(jnp.float32))
    A = -jnp.exp(A_log.astype(jnp.float32))
    y_ssd = ssd_chunked(xs.reshape(b, l, SSD_HEADS, SSD_HEAD_DIM), dt, A,
                        Bs.reshape(b, l, SSD_GROUPS, SSD_STATE), Cs.reshape(b, l, SSD_GROUPS, SSD_STATE), D_skip)
    y_ssd = rms_norm(y_ssd.reshape(b, l, SSD_INNER) * jax.nn.silu(z), ssd_norm)
    q = gq.reshape(b, l, GLA_HEADS, GLA_DK) * GLA_DK ** -0.5
    k = gk.reshape(b, l, GLA_HEADS, GLA_DK)
    v = gv.reshape(b, l, GLA_HEADS, GLA_DV)
    log_a = jax.nn.log_sigmoid((ga @ gla_w_gate + gla_b_gate).astype(jnp.float32)) / GLA_TAU
    o = gla_chunked(q, k, v, log_a.reshape(b, l, GLA_HEADS, GLA_DK))
    o = rms_norm(o, gla_norm.reshape(GLA_HEADS, GLA_DV))
    y_gla = o.reshape(b, l, GLA_VAL) * jax.nn.silu(gr)
    y = jnp.concatenate([y_ssd.astype(x.dtype), y_gla.astype(x.dtype)], axis=-1)
    return y @ w_out


def s5_mixer(u, A_re, A_im, log_step, B_re, B_im, C_re, C_im, D_skip, glu_w_a, glu_b_a, glu_w_b, glu_b_b):
    b, l, d = u.shape
    A_re = A_re.astype(jnp.float32)
    A_im = A_im.astype(jnp.float32)
    step = jnp.exp(log_step.astype(jnp.float32))[:, None]
    mag = jnp.exp(A_re * step)
    ab_re = mag * jnp.cos(A_im * step)
    ab_im = mag * jnp.sin(A_im * step)
    num_re = ab_re - 1.0
    den = jnp.square(A_re) + jnp.square(A_im)
    f_re = (num_re * A_re + ab_im * A_im) / den
    f_im = (ab_im * A_re - num_re * A_im) / den
    Bb_re = f_re[..., None] * B_re - f_im[..., None] * B_im
    Bb_im = f_re[..., None] * B_im + f_im[..., None] * B_re
    ug = u.reshape(b, l, S5_GROUPS, S5_GROUP)
    bu_re = jnp.einsum('gpc,blgc->blgp', Bb_re, ug)
    bu_im = jnp.einsum('gpc,blgc->blgp', Bb_im, ug)
    a_re = jnp.broadcast_to(ab_re, (1, l) + ab_re.shape)
    a_im = jnp.broadcast_to(ab_im, (1, l) + ab_im.shape)

    def combine(e1, e2):
        a1r, a1i, b1r, b1i = e1
        a2r, a2i, b2r, b2i = e2
        return (a2r * a1r - a2i * a1i, a2r * a1i + a2i * a1r,
                a2r * b1r - a2i * b1i + b2r, a2r * b1i + a2i * b1r + b2i)

    _, _, s_re, s_im = lax.associative_scan(combine, (a_re, a_im, bu_re, bu_im), axis=1)
    y = jnp.einsum('gcp,blgp->blgc', C_re, s_re) - jnp.einsum('gcp,blgp->blgc', C_im, s_im)
    y = y.reshape(b, l, d).astype(u.dtype) + D_skip * u
    y = jax.nn.gelu(y)
    return (y @ glu_w_a + glu_b_a) * jax.nn.sigmoid(y @ glu_w_b + glu_b_b)


def swiglu_ffn(x, w_gate, w_up, w_down):
    return (jax.nn.silu(x @ w_gate) * (x @ w_up)) @ w_down


def setup_inputs(seed: int = 0) -> dict:
    key = jax.random.key(seed)
    ks = iter(jax.random.split(key, 64))

    def nrm(shape, scale):
        return scale * jax.random.normal(next(ks), shape, jnp.float32)

    def gain(n):
        return 1.0 + nrm((n,), 0.02)

    def bias(n):
        return nrm((n,), 0.02)

    inp = {}
    inp['x'] = jax.random.normal(next(ks), (BATCH, SEQ, D_MODEL), jnp.float32)
    inp['l0_w_in'] = nrm((D_MODEL, IN_WIDTH), D_MODEL ** -0.5)
    inp['l0_conv_w'] = nrm((SSD_CONV, CONV_CH), SSD_CONV ** -0.5)
    inp['l0_conv_b'] = bias(CONV_CH)
    dt0 = jnp.exp(jax.random.uniform(next(ks), (SSD_HEADS,), jnp.float32, math.log(1e-3), math.log(1e-1)))
    inp['l0_dt_bias'] = dt0 + jnp.log(-jnp.expm1(-dt0))
    inp['l0_A_log'] = jnp.log(jax.random.uniform(next(ks), (SSD_HEADS,), jnp.float32, 1.0, 16.0))
    inp['l0_D'] = 1.0 + nrm((SSD_HEADS,), 0.1)
    inp['l0_ssd_norm'] = gain(SSD_INNER)
    inp['l0_gla_w_gate'] = nrm((GLA_RANK, GLA_KEY), GLA_RANK ** -0.5)
    inp['l0_gla_b_gate'] = bias(GLA_KEY)
    inp['l0_gla_norm'] = gain(GLA_VAL)
    inp['l0_w_out'] = nrm((MIX_WIDTH, D_MODEL), DN_BETA * MIX_WIDTH ** -0.5)
    inp['l0_ln1_g'] = gain(D_MODEL)
    inp['l0_ln1_b'] = bias(D_MODEL)
    inp['l0_ffn_w_gate'] = nrm((D_MODEL, FFN_HIDDEN), D_MODEL ** -0.5)
    inp['l0_ffn_w_up'] = nrm((D_MODEL, FFN_HIDDEN), D_MODEL ** -0.5)
    inp['l0_ffn_w_down'] = nrm((FFN_HIDDEN, D_MODEL), DN_BETA * FFN_HIDDEN ** -0.5)
    inp['l0_ln2_g'] = gain(D_MODEL)
    inp['l0_ln2_b'] = bias(D_MODEL)
    inp['l1_s5_A_re'] = -0.5 + nrm((S5_GROUPS, S5_STATE), 0.01)
    inp['l1_s5_A_im'] = jnp.broadcast_to(jnp.pi * jnp.arange(S5_STATE, dtype=jnp.float32), (S5_GROUPS, S5_STATE)) + nrm((S5_GROUPS, S5_STATE), 0.01)
    inp['l1_s5_log_step'] = jax.random.uniform(next(ks), (S5_GROUPS,), jnp.float32, math.log(1e-3), math.log(1e-1))
    inp['l1_s5_B_re'] = nrm((S5_GROUPS, S5_STATE, S5_GROUP), (2 * S5_GROUP) ** -0.5)
    inp['l1_s5_B_im'] = nrm((S5_GROUPS, S5_STATE, S5_GROUP), (2 * S5_GROUP) ** -0.5)
    inp['l1_s5_C_re'] = nrm((S5_GROUPS, S5_GROUP, S5_STATE), (2 * S5_STATE) ** -0.5 * 4.0)
    inp['l1_s5_C_im'] = nrm((S5_GROUPS, S5_GROUP, S5_STATE), (2 * S5_STATE) ** -0.5 * 4.0)
    inp['l1_s5_D'] = nrm((D_MODEL,), 0.5)
    inp['l1_glu_w_a'] = nrm((D_MODEL, D_MODEL), DN_BETA * D_MODEL ** -0.5)
    inp['l1_glu_b_a'] = bias(D_MODEL)
    inp['l1_glu_w_b'] = nrm((D_MODEL, D_MODEL), D_MODEL ** -0.5)
    inp['l1_glu_b_b'] = bias(D_MODEL)
    inp['l1_ln1_g'] = gain(D_MODEL)
    inp['l1_ln1_b'] = bias(D_MODEL)
    inp['l1_ffn_w_gate'] = nrm((D_MODEL, FFN_HIDDEN), D_MODEL ** -0.5)
    inp['l1_ffn_w_up'] = nrm((D_MODEL, FFN_HIDDEN), D_MODEL ** -0.5)
    inp['l1_ffn_w_down'] = nrm((FFN_HIDDEN, D_MODEL), DN_BETA * FFN_HIDDEN ** -0.5)
    inp['l1_ln2_g'] = gain(D_MODEL)
    inp['l1_ln2_b'] = bias(D_MODEL)
    return inp


def reference(x, l0_w_in, l0_conv_w, l0_conv_b, l0_dt_bias, l0_A_log, l0_D, l0_ssd_norm,
              l0_gla_w_gate, l0_gla_b_gate, l0_gla_norm, l0_w_out, l0_ln1_g, l0_ln1_b,
              l0_ffn_w_gate, l0_ffn_w_up, l0_ffn_w_down, l0_ln2_g, l0_ln2_b,
              l1_s5_A_re, l1_s5_A_im, l1_s5_log_step, l1_s5_B_re, l1_s5_B_im, l1_s5_C_re, l1_s5_C_im,
              l1_s5_D, l1_glu_w_a, l1_glu_b_a, l1_glu_w_b, l1_glu_b_b, l1_ln1_g, l1_ln1_b,
              l1_ffn_w_gate, l1_ffn_w_up, l1_ffn_w_down, l1_ln2_g, l1_ln2_b):
    mixer_params = [
        (l0_w_in, l0_conv_w, l0_conv_b, l0_dt_bias, l0_A_log, l0_D, l0_ssd_norm,
         l0_gla_w_gate, l0_gla_b_gate, l0_gla_norm, l0_w_out),
        (l1_s5_A_re, l1_s5_A_im, l1_s5_log_step, l1_s5_B_re, l1_s5_B_im, l1_s5_C_re, l1_s5_C_im,
         l1_s5_D, l1_glu_w_a, l1_glu_b_a, l1_glu_w_b, l1_glu_b_b),
    ]
    norm1 = [(l0_ln1_g, l0_ln1_b), (l1_ln1_g, l1_ln1_b)]
    ffn_params = [(l0_ffn_w_gate, l0_ffn_w_up, l0_ffn_w_down), (l1_ffn_w_gate, l1_ffn_w_up, l1_ffn_w_down)]
    norm2 = [(l0_ln2_g, l0_ln2_b), (l1_ln2_g, l1_ln2_b)]
    for layer in range(DEPTH):
        if layer % 2 == 0:
            h = ssd_gla_mixer(x, *mixer_params[layer])
        else:
            h = s5_mixer(x, *mixer_params[layer])
        x = layer_norm(DN_ALPHA * x + h, *norm1[layer])
        x = layer_norm(DN_ALPHA * x + swiglu_ffn(x, *ffn_params[layer]), *norm2[layer])
    return x
```

```cpp
#include <hip/hip_runtime.h>
#include <hip/hip_cooperative_groups.h>
#include <cstdio>
#include <cstdint>
namespace cg = cooperative_groups;

#define DI __device__ __forceinline__
typedef unsigned short bf16_t;
typedef short bf16x8 __attribute__((ext_vector_type(8)));
typedef float f32x16 __attribute__((ext_vector_type(16)));
typedef float f32x4 __attribute__((ext_vector_type(4)));
typedef unsigned u32x4 __attribute__((ext_vector_type(4)));
typedef unsigned u32x2 __attribute__((ext_vector_type(2)));

#define MFMA(a, b, c) __builtin_amdgcn_mfma_f32_32x32x16_bf16((a), (b), (c), 0, 0, 0)

constexpr int M_ = 16384, D_ = 1024, L_ = 8192;
constexpr int NTHREADS = 256;
constexpr int NT = 512;
constexpr int VB_LDS = 36864;
#define VB (T_ >> 8)
#define VTID (T_ & 255)
__device__ __forceinline__ int opaque_tid() { int t = threadIdx.x; asm volatile("" : "+v"(t)); return t; }
constexpr float DN_ALPHA = 1.4142135623730951f;
constexpr float LN_EPS = 1e-5f;
constexpr int FFH = 2816;
constexpr int NIN = 5888;

constexpr size_t SZ_WT_IN = (size_t)NIN * 1024 * 2;
constexpr size_t SZ_WT_OUT = (size_t)1024 * 2048 * 2;
constexpr size_t SZ_WT_GU = (size_t)5632 * 1024 * 2;
constexpr size_t SZ_WT_DN = (size_t)1024 * 2816 * 2;
constexpr size_t SZ_WT_GLU = (size_t)2048 * 1024 * 2;
constexpr size_t OFF_WT_IN = 0;
constexpr size_t OFF_WT_OUT = OFF_WT_IN + SZ_WT_IN;
constexpr size_t OFF_WT_GU0 = OFF_WT_OUT + SZ_WT_OUT;
constexpr size_t OFF_WT_DN0 = OFF_WT_GU0 + SZ_WT_GU;
constexpr size_t OFF_U = OFF_WT_DN0 + SZ_WT_DN;
constexpr size_t SZ_U = (size_t)M_ * 1024 * 4;
constexpr size_t OFF_XT = OFF_U;
constexpr size_t OFF_BTM = OFF_XT + (size_t)1024 * M_ * 2;
constexpr size_t OFF_CTM = OFF_BTM + (size_t)M_ * 256 * 2;
constexpr size_t OFF_BT = OFF_CTM + (size_t)M_ * 256 * 2;
constexpr size_t OFF_H = OFF_U + SZ_U;
constexpr size_t SZ_H = (size_t)M_ * 3584 * 2;
constexpr size_t OFF_Z = OFF_H;
constexpr size_t OFF_R = OFF_Z + (size_t)M_ * 1024 * 2;
constexpr size_t OFF_Q = OFF_R + (size_t)M_ * 1024 * 2;
constexpr size_t OFF_K = OFF_Q + (size_t)M_ * 512 * 2;
constexpr size_t OFF_KT = OFF_K + (size_t)M_ * 512 * 2;
constexpr size_t OFF_HMID = OFF_H;
constexpr size_t OFF_W1 = OFF_H + (size_t)M_ * 2816 * 2;
constexpr size_t OFF_WT_GLU = OFF_W1;
constexpr size_t OFF_WT_GU1 = OFF_WT_GLU + SZ_WT_GLU;
constexpr size_t OFF_WT_DN1 = OFF_WT_GU1 + SZ_WT_GU;
static_assert(OFF_WT_DN1 + SZ_WT_DN <= OFF_H + SZ_H, "W1 must fit in H tail");
constexpr size_t OFF_SLOC = OFF_H;
constexpr int S5CH = 128, S5NCH = M_ / S5CH, S5CPB = L_ / S5CH, S5TILES = S5CH / 32;
constexpr size_t OFF_SENT = OFF_SLOC + (size_t)256 * 64 * 64 * 2 * 4;
constexpr size_t OFF_VT = OFF_H + SZ_H;
constexpr size_t OFF_SM = OFF_VT + (size_t)1024 * M_ * 2;
constexpr size_t OFF_DT = OFF_SM;
constexpr size_t OFF_GA = OFF_DT + (size_t)M_ * 16 * 4;
constexpr size_t OFF_DAC = OFF_GA + (size_t)M_ * 16 * 4;
constexpr size_t OFF_WST = OFF_DAC + (size_t)M_ * 16 * 4;
constexpr size_t OFF_SSQ = OFF_WST + (size_t)M_ * 16 * 4;
constexpr size_t OFF_XHALO = OFF_SSQ + (size_t)M_ * 4;
constexpr size_t OFF_BCHALO = OFF_XHALO + (size_t)128 * 1024 * 4 * 2;
constexpr size_t OFF_CDEC = OFF_BCHALO + (size_t)128 * 4 * 512 * 2;
constexpr size_t OFF_GREF = OFF_CDEC + (size_t)128 * 16 * 4;
constexpr size_t OFF_GLAST = OFF_GREF + (size_t)128 * 512 * 4;
constexpr size_t OFF_CSC = OFF_GLAST + (size_t)128 * 512 * 4;
constexpr size_t WS_END = OFF_CSC + (size_t)128 * 512 * 4;
constexpr size_t OFF_S5AB = (WS_END + 255) & ~(size_t)255;
constexpr size_t OFF_S5BB = OFF_S5AB + (size_t)64 * 64 * 2 * 4;
constexpr size_t OFF_S5CM = OFF_S5BB + (size_t)64 * 4 * 2 * 32 * 8 * 2;
constexpr size_t OFF_BAR = OFF_S5CM + (size_t)64 * 8 * 2 * 32 * 8 * 2;
constexpr size_t WS_TOTAL = OFF_BAR + 3456 * 4;
static_assert(WS_TOTAL <= (size_t)256 * 1024 * 1024, "workspace overflow");
constexpr size_t OUT_HALF = (size_t)M_ * 1024 * 2;

struct Params {
    const float* in[38];
    float* out;
    unsigned char* ws;
    int ph_lo, ph_hi;
};

typedef __bf16 hwbf2 __attribute__((ext_vector_type(2)));
typedef float f32x2h __attribute__((ext_vector_type(2)));
DI bf16_t f2bf(float x) { return __builtin_bit_cast(bf16_t, (__bf16)x); }
DI float bf2f(bf16_t b) { return __uint_as_float(((unsigned)b) << 16); }
DI unsigned pack2(float a, float b) { f32x2h v; v.x = a; v.y = b; return __builtin_bit_cast(unsigned, __builtin_convertvector(v, hwbf2)); }
DI float bflo(unsigned u) { return __uint_as_float(u << 16); }
DI float bfhi(unsigned u) { return __uint_as_float(u & 0xffff0000u); }
DI int crow(int reg, int h) { return (reg & 3) + 8 * (reg >> 2) + 4 * h; }
DI size_t tidx(int ch, int tok) { return ((((size_t)(ch >> 5) * (M_ / 16) + (tok >> 4)) * 2 + ((tok >> 3) & 1)) * 32 + (ch & 31)) * 8 + (tok & 7); }
DI int sidx2(int row, int k) { return ((((row >> 5) * 8 + (k >> 4)) * 2 + ((k >> 3) & 1)) * 32 + (row & 31)) * 8 + (k & 7); }
DI float sigmoidf_(float x) { return __builtin_amdgcn_rcpf(1.f + __expf(-x)); }
DI float siluf_(float x) { return x * sigmoidf_(x); }
DI float softplusf_(float x) { return fmaxf(x, 0.f) + log1pf(__expf(-fabsf(x))); }
DI float logsigmoidf_(float x) { return fminf(x, 0.f) - log1pf(__expf(-fabsf(x))); }
DI float gelu_tanh(float y) { const float t = 0.7978845608028654f * (y + 0.044715f * y * y * y); const float th = 1.f - 2.f * __builtin_amdgcn_rcpf(__expf(2.f * t) + 1.f); return 0.5f * y * (1.f + th); }
DI bf16x8 as_bf16x8(u32x4 v) { return __builtin_bit_cast(bf16x8, v); }
DI bf16x8 ld_frag(const bf16_t* p) { return as_bf16x8(*(const u32x4*)p); }
DI bf16x8 ld_frag2(const bf16_t* p0, const bf16_t* p1) { u32x2 a = *(const u32x2*)p0, b = *(const u32x2*)p1; u32x4 v; v.x = a.x; v.y = a.y; v.z = b.x; v.w = b.y; return as_bf16x8(v); }
DI f32x16 zero16() { f32x16 z; for (int i = 0; i < 16; ++i) z[i] = 0.f; return z; }
DI bf16x8 pack_step(const f32x16& x, int s) { u32x4 v; v.x = pack2(x[8 * s], x[8 * s + 1]); v.y = pack2(x[8 * s + 2], x[8 * s + 3]); v.z = pack2(x[8 * s + 4], x[8 * s + 5]); v.w = pack2(x[8 * s + 6], x[8 * s + 7]); return as_bf16x8(v); }
DI float half_reduce(float v) {
    v += __shfl_xor(v, 1); v += __shfl_xor(v, 2); v += __shfl_xor(v, 4); v += __shfl_xor(v, 8); v += __shfl_xor(v, 16); return v;
}

typedef float f32x4v __attribute__((ext_vector_type(4)));
namespace g8 {
constexpr int BM = 256, BKK = 64, HALF = 128, HT = HALF * BKK, SHM_B = 8 * HT * 2, NXCD = 8, WGM = 8;
DI int lds_byte(int r, int c) { const int st = (r >> 4) * 2 + (c >> 5), rr = r & 15, cc = c & 31, ob = rr * 64 + cc * 2; return st * 1024 + (ob ^ (((ob >> 9) & 1) << 5)); }
DI void stage_rc(int b, int& R, int& C) { const int st = b / 1024, sb = b % 1024, swz = sb ^ (((sb >> 9) & 1) << 5); R = (st >> 1) * 16 + swz / 64; C = (st & 1) * 32 + (swz % 64) / 2; }

template <class Epi>
DI void tile(const bf16_t* __restrict__ A, int lda, const bf16_t* __restrict__ Bt, int ldb, int K, int brow, int bcol, bool first, bool has_next, int nbrow, int nbcol, bf16_t* shm, const Epi& epi) {
#define SA(b, h) (shm + ((b) * 4 + (h)) * HT)
#define SB(b, h) (shm + ((b) * 4 + 2 + (h)) * HT)
#define STAGE(P, BASE, OFF, LD, br, kt) do { const bf16_t* _g = (BASE) + ((size_t)(br) * (LD) + (size_t)(kt) * BKK); \
    _Pragma("unroll") for (int _i = 0; _i < 2; ++_i) { \
      __builtin_amdgcn_global_load_lds((const unsigned*)(_g + OFF[_i]), (__attribute__((address_space(3))) unsigned*)((char*)(P) + tx * 16 + _i * 8192), 16, 0, 0); } } while (0)
#define LDA(dst, b, h) _Pragma("unroll") for (int m = 0; m < 4; ++m) _Pragma("unroll") for (int k = 0; k < 2; ++k) \
    dst[m][k] = *reinterpret_cast<const bf16x8*>((char*)SA(b, h) + lds_byte(wr * 64 + m * 16 + fr, k * 32 + fq * 8))
#define LDB(dst, b, h) _Pragma("unroll") for (int n = 0; n < 2; ++n) _Pragma("unroll") for (int k = 0; k < 2; ++k) \
    dst[n][k] = *reinterpret_cast<const bf16x8*>((char*)SB(b, h) + lds_byte(wc * 32 + n * 16 + fr, k * 32 + fq * 8))
#define MMA(ai, bj, At_, Bt_) do { __builtin_amdgcn_s_setprio(1); \
    _Pragma("unroll") for (int m = 0; m < 4; ++m) _Pragma("unroll") for (int n = 0; n < 2; ++n) _Pragma("unroll") for (int k = 0; k < 2; ++k) \
      acc[ai][bj][m][n] = __builtin_amdgcn_mfma_f32_16x16x32_bf16(At_[m][k], Bt_[n][k], acc[ai][bj][m][n], 0, 0, 0); \
    __builtin_amdgcn_s_setprio(0); } while (0)
#define WAIT_V(n) asm volatile("s_waitcnt vmcnt(" #n ")" ::: "memory")
#define WAIT_L(n) asm volatile("s_waitcnt lgkmcnt(" #n ")" ::: "memory")
#define BAR __builtin_amdgcn_s_barrier()
#define SCHED __builtin_amdgcn_sched_barrier(0)
    int tx = threadIdx.x;
    asm volatile("" : "+v"(tx));
    const int wid = tx >> 6, lane = tx & 63, wr = __builtin_amdgcn_readfirstlane(wid >> 2), wc = __builtin_amdgcn_readfirstlane(wid & 3), fr = lane & 15, fq = lane >> 4;
    unsigned offA[2], offB[2];
#pragma unroll
    for (int i = 0; i < 2; ++i) { int r_, c_; stage_rc(tx * 16 + i * 8192, r_, c_); offA[i] = (unsigned)(r_ * lda + c_); offB[i] = (unsigned)(r_ * ldb + c_); }
    f32x4v acc[2][2][4][2];
#pragma unroll
    for (int a = 0; a < 2; ++a)
#pragma unroll
        for (int b = 0; b < 2; ++b)
#pragma unroll
            for (int m = 0; m < 4; ++m)
#pragma unroll
                for (int n = 0; n < 2; ++n) acc[a][b][m][n] = (f32x4v){0.f, 0.f, 0.f, 0.f};
    bf16x8 At[4][2], B0[2][2], B1[2][2];
    const int nt = K / BKK;
    WAIT_V(0);
    if (first) {
        STAGE(SB(0, 0), Bt, offB, ldb, bcol, 0); STAGE(SA(0, 0), A, offA, lda, brow, 0);
        STAGE(SB(0, 1), Bt, offB, ldb, bcol + HALF, 0); STAGE(SA(0, 1), A, offA, lda, brow + HALF, 0);
    }
    if (wr == 1) BAR;
    if (first) WAIT_V(4);
    BAR;
    STAGE(SB(1, 0), Bt, offB, ldb, bcol, 1); STAGE(SA(1, 0), A, offA, lda, brow, 1); STAGE(SB(1, 1), Bt, offB, ldb, bcol + HALF, 1);
    WAIT_V(6); BAR;
#pragma unroll 1
    for (int t = 0; t < nt - 2; t += 2) {
        LDB(B0, 0, 0); SCHED; LDA(At, 0, 0); STAGE(SA(1, 1), A, offA, lda, brow + HALF, t + 1);
        WAIT_L(8); BAR; WAIT_L(0); MMA(0, 0, At, B0); BAR; SCHED;
        LDB(B1, 0, 1); STAGE(SB(0, 0), Bt, offB, ldb, bcol, t + 2);
        BAR; WAIT_L(0); MMA(0, 1, At, B1); BAR;
        LDA(At, 0, 1); STAGE(SA(0, 0), A, offA, lda, brow, t + 2);
        BAR; WAIT_L(0); MMA(1, 0, At, B0); BAR; SCHED;
        STAGE(SB(0, 1), Bt, offB, ldb, bcol + HALF, t + 2);
        WAIT_V(6); BAR; MMA(1, 1, At, B1); BAR;
        LDB(B0, 1, 0); SCHED; LDA(At, 1, 0); STAGE(SA(0, 1), A, offA, lda, brow + HALF, t + 2);
        WAIT_L(8); BAR; WAIT_L(0); MMA(0, 0, At, B0); BAR; SCHED;
        LDB(B1, 1, 1); STAGE(SB(1, 0), Bt, offB, ldb, bcol, t + 3);
        BAR; WAIT_L(0); MMA(0, 1, At, B1); BAR;
        LDA(At, 1, 1); STAGE(SA(1, 0), A, offA, lda, brow, t + 3);
        BAR; WAIT_L(0); MMA(1, 0, At, B0); BAR; SCHED;
        STAGE(SB(1, 1), Bt, offB, ldb, bcol + HALF, t + 3);
        WAIT_V(6); BAR; MMA(1, 1, At, B1); BAR;
    }
    { LDB(B0, 0, 0); LDA(At, 0, 0); STAGE(SA(1, 1), A, offA, lda, brow + HALF, nt - 1);
      BAR; WAIT_L(0); MMA(0, 0, At, B0); BAR;
      LDB(B1, 0, 1); BAR; WAIT_L(0); MMA(0, 1, At, B1); BAR;
      LDA(At, 0, 1); WAIT_V(4); BAR; WAIT_L(0); MMA(1, 0, At, B0); MMA(1, 1, At, B1); BAR; }
    { LDB(B0, 1, 0); LDA(At, 1, 0); WAIT_V(2); BAR; WAIT_L(0); MMA(0, 0, At, B0); BAR;
      LDB(B1, 1, 1); WAIT_V(0); BAR; WAIT_L(0); MMA(0, 1, At, B1); BAR;
      LDA(At, 1, 1); BAR; WAIT_L(0); MMA(1, 0, At, B0); MMA(1, 1, At, B1); BAR; }
    if (wr == 0) BAR;
    {
        int t2 = threadIdx.x;
        asm volatile("" : "+v"(t2));
        if (has_next) {
            unsigned oA[2], oB[2];
#pragma unroll
            for (int i = 0; i < 2; ++i) { int r_, c_; stage_rc(t2 * 16 + i * 8192, r_, c_); oA[i] = (unsigned)(r_ * lda + c_); oB[i] = (unsigned)(r_ * ldb + c_); }
            const int tx = t2;
            STAGE(SB(0, 0), Bt, oB, ldb, nbcol, 0); STAGE(SA(0, 0), A, oA, lda, nbrow, 0);
            STAGE(SB(0, 1), Bt, oB, ldb, nbcol + HALF, 0); STAGE(SA(0, 1), A, oA, lda, nbrow + HALF, 0);
        }
        float* stg = (float*)(shm + 4 * HT);
        const int wr2 = t2 >> 8, wc2 = (t2 >> 6) & 3, fr2 = t2 & 15, fq2 = (t2 >> 4) & 3;
#pragma unroll
        for (int q = 0; q < 4; ++q) {
            const int ai = q >> 1, bj = q & 1;
            typename Epi::Pre pre;
            epi.pre(pre, brow + ai * 128, bcol + bj * 128, t2);
#pragma unroll
            for (int m = 0; m < 4; ++m)
#pragma unroll
                for (int n = 0; n < 2; ++n)
#pragma unroll
                    for (int j = 0; j < 4; ++j)
                        stg[(wr2 * 64 + m * 16 + fq2 * 4 + j) * 128 + ((wc2 * 32 + n * 16 + fr2) ^ (fq2 << 4))] = acc[ai][bj][m][n][j];
            WAIT_L(0); BAR;
            epi.quarter(stg, brow + ai * 128, bcol + bj * 128, t2, pre);
            WAIT_L(0); BAR;
        }
    }
#undef SA
#undef SB
#undef STAGE
#undef LDA
#undef LDB
#undef MMA
#undef WAIT_V
#undef WAIT_L
#undef BAR
#undef SCHED
}

DI void tile_coords(int L, int nM, int nN, int& pm, int& pn) {
    const int nwg = nM * nN;
    int wgid = L;
    { const int q = nwg / NXCD, r = nwg % NXCD, xcd = wgid % NXCD, off = wgid / NXCD; wgid = (xcd < r ? xcd * (q + 1) : r * (q + 1) + (xcd - r) * q) + off; }
    const int nig = WGM * nN, gid = wgid / nig, fm = gid * WGM, gsz = (nM - fm) < WGM ? (nM - fm) : WGM;
    pm = fm + ((wgid % nig) % gsz); pn = (wgid % nig) / gsz;
}
template <class Epi>
DI void phase(const bf16_t* A, int lda, const bf16_t* Bt, int ldb, int K, int Mrows, int Ncols, bf16_t* shm, const Epi& epi) {
    const int nM = Mrows / BM, nN = Ncols / BM, nwg = nM * nN;
    bool first = true;
    for (int L = blockIdx.x; L < nwg; L += gridDim.x) {
        int pm, pn, qm = 0, qn = 0;
        tile_coords(L, nM, nN, pm, pn);
        const bool has_next = (L + (int)gridDim.x) < nwg;
        if (has_next) tile_coords(L + gridDim.x, nM, nN, qm, qn);
        tile(A, lda, Bt, ldb, K, pm * BM, pn * BM, first, has_next, qm * BM, qn * BM, shm, epi);
        first = false;
    }
    asm volatile("s_waitcnt vmcnt(0)" ::: "memory");
}
}

DI int sidx(int rl, int c) { return rl * 128 + (c ^ (((rl >> 2) & 3) << 4)); }
DI u32x4 pack8(const f32x4& a, const f32x4& b) { u32x4 v; v.x = pack2(a[0], a[1]); v.y = pack2(a[2], a[3]); v.z = pack2(b[0], b[1]); v.w = pack2(b[2], b[3]); return v; }
DI void quarter_store_bf16(const float* stg, bf16_t* dst, int ld, int r0, int cdst, float scale, int t) {
    const int c8 = (t & 15) * 8;
#pragma unroll 2
    for (int i = 0; i < 4; ++i) {
        const int rl = (t >> 4) + 32 * i;
        f32x4 a = *(const f32x4*)(stg + sidx(rl, c8)), b = *(const f32x4*)(stg + sidx(rl, c8 + 4));
        a *= scale; b *= scale;
        *(u32x4*)(dst + (size_t)(r0 + rl) * ld + cdst + c8) = pack8(a, b);
    }
}
DI void quarter_store_T(const float* stg, bf16_t* dstT, int ch0, int r0, bf16_t* halo, int t) {
    const int col = t & 127;
#pragma unroll 2
    for (int i = 0; i < 4; ++i) {
        const int r8 = (t >> 7) + 4 * i;
        float v[8];
#pragma unroll
        for (int jj = 0; jj < 8; ++jj) v[jj] = stg[sidx(8 * r8 + jj, col)];
        u32x4 pk; pk.x = pack2(v[0], v[1]); pk.y = pack2(v[2], v[3]); pk.z = pack2(v[4], v[5]); pk.w = pack2(v[6], v[7]);
        *(u32x4*)(dstT + tidx(ch0 + col, r0 + 8 * r8)) = pk;
        if (halo && r8 == 15) { u32x2 h; h.x = pk.z; h.y = pk.w; *(u32x2*)(halo + ((size_t)(r0 >> 7) * 1024 + ch0 + col) * 4) = h; }
    }
}
struct EpiInProj {
    struct Pre {}; DI void pre(Pre&, int, int, int) const {}
    bf16_t *z, *xT, *btm, *ctm, *q, *k, *vT, *r, *xhalo, *bchalo; float *dt, *ga; const float* dt_bias;
    DI void quarter(const float* stg, int r0, int c0, int t, const Pre& pre) const {
        if (c0 < 1024) quarter_store_bf16(stg, z, 1024, r0, c0, 1.f, t);
        else if (c0 < 2048) quarter_store_T(stg, xT, c0 - 1024, r0, xhalo, t);
        else if (c0 < 2560) {
            const int cb = c0 - 2048;
            quarter_store_bf16(stg, cb < 256 ? btm : ctm, 256, r0, cb & 255, 1.f, t);
            if (t < 64) {
                const int rl = 124 + (t >> 4), c8 = (t & 15) * 8;
                const f32x4 a = *(const f32x4*)(stg + sidx(rl, c8)), b = *(const f32x4*)(stg + sidx(rl, c8 + 4));
                *(u32x4*)(bchalo + ((size_t)(r0 >> 7) * 4 + (t >> 4)) * 512 + cb + c8) = pack8(a, b);
            }
        }
        else if (c0 < 3072) quarter_store_bf16(stg, q, 512, r0, c0 - 2560, 0.08838834764831845f, t);
        else if (c0 < 3584) quarter_store_bf16(stg, k, 512, r0, c0 - 3072, 1.f, t);
        else if (c0 < 4608) quarter_store_T(stg, vT, c0 - 3584, r0, nullptr, t);
        else if (c0 < 5632) quarter_store_bf16(stg, r, 1024, r0, c0 - 4608, 1.f, t);
        else if (c0 == 5632) {
            int tt = t;
            asm volatile("" : "+v"(tt));
            const int c = tt & 31;
            const float bias = c < 16 ? dt_bias[c] : 0.f;
#pragma unroll 2
            for (int i = 0; i < 8; ++i) {
                const int rl = (tt >> 5) + 16 * i;
                const float v = stg[sidx(rl, c)];
                if (c < 16) dt[(size_t)(r0 + rl) * 16 + c] = softplusf_(v + bias);
                else ga[(size_t)(r0 + rl) * 16 + c - 16] = v;
            }
        }
    }
};

template <int MODE>
struct EpiResidual {
    float* U; const float* X; const float* ssq;
    struct Pre { f32x4 x[4][2]; };
    DI void pre(Pre& P, int r0, int c0, int t) const {
        const float* src = (MODE == 0) ? X : U;
        const int c8 = (t & 15) * 8;
#pragma unroll
        for (int i = 0; i < 4; ++i) { const size_t idx = (size_t)(r0 + (t >> 4) + 32 * i) * 1024 + c0 + c8; P.x[i][0] = *(const f32x4*)(src + idx); P.x[i][1] = *(const f32x4*)(src + idx + 4); }
    }
    DI void quarter(const float* stg, int r0, int c0, int t, const Pre& pre) const {
        const int c8 = (t & 15) * 8;
#pragma unroll
        for (int i = 0; i < 4; ++i) {
            const int rl = (t >> 4) + 32 * i;
            const f32x4 a = *(const f32x4*)(stg + sidx(rl, c8)), b = *(const f32x4*)(stg + sidx(rl, c8 + 4));
            const size_t idx = (size_t)(r0 + rl) * 1024 + c0 + c8;
            if (MODE == 0) {
                const f32x4 xa = pre.x[i][0], xb2 = pre.x[i][1];
                *(f32x4*)(U + idx) = xa * DN_ALPHA + a; *(f32x4*)(U + idx + 4) = xb2 * DN_ALPHA + b;
            } else {
                const float sc = rsqrtf(ssq[r0 + rl] * (1.f / 1024.f) + LN_EPS);
                const f32x4 ua = pre.x[i][0], ub = pre.x[i][1];
                *(f32x4*)(U + idx) = ua + a * sc; *(f32x4*)(U + idx + 4) = ub + b * sc;
            }
        }
    }
};

struct EpiSwiGLU {
    struct Pre {}; DI void pre(Pre&, int, int, int) const {}
    bf16_t* hmid;
    DI void quarter(const float* stg, int r0, int c0, int t, const Pre& pre) const {
        const int u8 = (t & 7) * 8, cg = (u8 >> 4) * 32 + (u8 & 15);
#pragma unroll 1
        for (int i = 0; i < 2; ++i) {
            const int rl = (t >> 3) + 64 * i;
            const f32x4 g0 = *(const f32x4*)(stg + sidx(rl, cg)), g1 = *(const f32x4*)(stg + sidx(rl, cg + 4)), u0 = *(const f32x4*)(stg + sidx(rl, cg + 16)), u1 = *(const f32x4*)(stg + sidx(rl, cg + 20));
            f32x4 o0, o1;
#pragma unroll
            for (int e = 0; e < 4; ++e) { o0[e] = siluf_(g0[e]) * u0[e]; o1[e] = siluf_(g1[e]) * u1[e]; }
            *(u32x4*)(hmid + (size_t)(r0 + rl) * FFH + (c0 >> 1) + u8) = pack8(o0, o1);
        }
    }
};
struct EpiGLU {
    struct Pre { f32x4 u[2][2]; };
    DI void pre(Pre& P, int r0, int c0, int t) const {
        const int u8 = (t & 7) * 8, unit = (c0 >> 1) + u8;
#pragma unroll
        for (int i = 0; i < 2; ++i) { const size_t idx = (size_t)(r0 + (t >> 3) + 64 * i) * 1024 + unit; P.u[i][0] = *(const f32x4*)(U + idx); P.u[i][1] = *(const f32x4*)(U + idx + 4); }
    }
    float* U; const float *ba, *bb;
    DI void quarter(const float* stg, int r0, int c0, int t, const Pre& pre) const {
        const int u8 = (t & 7) * 8, cg = (u8 >> 4) * 32 + (u8 & 15);
        const int unit = (c0 >> 1) + u8;
        const f32x4 ba0 = *(const f32x4*)(ba + unit), ba1 = *(const f32x4*)(ba + unit + 4), bb0 = *(const f32x4*)(bb + unit), bb1 = *(const f32x4*)(bb + unit + 4);
#pragma unroll
        for (int i = 0; i < 2; ++i) {
            const int rl = (t >> 3) + 64 * i;
            const f32x4 a0 = *(const f32x4*)(stg + sidx(rl, cg)), a1 = *(const f32x4*)(stg + sidx(rl, cg + 4)), b0 = *(const f32x4*)(stg + sidx(rl, cg + 16)), b1 = *(const f32x4*)(stg + sidx(rl, cg + 20));
            const size_t idx = (size_t)(r0 + rl) * 1024 + unit;
            f32x4 o0 = pre.u[i][0], o1 = pre.u[i][1];
#pragma unroll
            for (int e = 0; e < 4; ++e) {
                o0[e] = DN_ALPHA * o0[e] + (a0[e] + ba0[e]) * sigmoidf_(b0[e] + bb0[e]);
                o1[e] = DN_ALPHA * o1[e] + (a1[e] + ba1[e]) * sigmoidf_(b1[e] + bb1[e]);
            }
            *(f32x4*)(U + idx) = o0; *(f32x4*)(U + idx + 4) = o1;
        }
    }
};

struct ColSrc { const float* p; int ld; };
template <class MapFn>
DI void prep_wt_units(bf16_t* dst, int Nd, int K, const MapFn& mapfn, float* lds, int vb0, int nvb) {
    const int T_ = opaque_tid();
    const int nkt = K / 64, nun = (Nd / 64) * nkt;
    const int tid = VTID;
    const int nn_l = tid & 63, kq_l = tid >> 6;
    float vals[16];
    int uu = vb0;
    if (uu < nun) {
        const int nt = uu / nkt, kt = uu % nkt;
        const ColSrc cs = mapfn(nt * 64 + nn_l);
#pragma unroll
        for (int i = 0; i < 16; ++i) vals[i] = cs.p ? cs.p[(size_t)(kt * 64 + i * 4 + kq_l) * cs.ld] : 0.f;
    }
    for (; uu < nun; uu += nvb) {
        const int nt = uu / nkt, kt = uu % nkt, n0 = nt * 64, k0 = kt * 64;
#pragma unroll
        for (int i = 0; i < 16; ++i) lds[(i * 4 + kq_l) * 65 + nn_l] = vals[i];
        __syncthreads();
        const int un = uu + nvb;
        if (un < nun) {
            const int nt2 = un / nkt, kt2 = un % nkt;
            const ColSrc cs = mapfn(nt2 * 64 + nn_l);
#pragma unroll
            for (int i = 0; i < 16; ++i) vals[i] = cs.p ? cs.p[(size_t)(kt2 * 64 + i * 4 + kq_l) * cs.ld] : 0.f;
        }
        {
            const int nn = tid >> 2, kq = tid & 3;
            u32x4 v0, v1;
            const float* sp = lds + (kq * 16) * 65 + nn;
            v0.x = pack2(sp[0 * 65], sp[1 * 65]); v0.y = pack2(sp[2 * 65], sp[3 * 65]); v0.z = pack2(sp[4 * 65], sp[5 * 65]); v0.w = pack2(sp[6 * 65], sp[7 * 65]);
            v1.x = pack2(sp[8 * 65], sp[9 * 65]); v1.y = pack2(sp[10 * 65], sp[11 * 65]); v1.z = pack2(sp[12 * 65], sp[13 * 65]); v1.w = pack2(sp[14 * 65], sp[15 * 65]);
            bf16_t* d = dst + (size_t)(n0 + nn) * K + k0 + kq * 16;
            *(u32x4*)d = v0; *(u32x4*)(d + 8) = v1;
        }
        __syncthreads();
    }
}

struct MapIn { const float* w;
    DI ColSrc operator()(int n) const {
        int src;
        if (n < 2560) src = n; else if (n < 3072) src = 2576 + (n - 2560); else if (n < 3584) src = 3088 + (n - 3072);
        else if (n < 4608) src = 3600 + (n - 3584); else if (n < 5632) src = 4624 + (n - 4608); else if (n < 5648) src = 2560 + (n - 5632);
        else if (n < 5664) src = n; else return ColSrc{nullptr, 0};
        return ColSrc{w + src, 5664};
    } };
struct MapPlain { const float* w; int ld; DI ColSrc operator()(int n) const { return ColSrc{w + n, ld}; } };
struct MapPair { const float *wa, *wb; int ld;
    DI ColSrc operator()(int n) const { const int unit = (n >> 5) * 16 + (n & 15); return ColSrc{((n >> 4) & 1) ? wb + unit : wa + unit, ld}; } };

DI void phase_prep0(const Params& p, unsigned char* smem) {
    const int T_ = opaque_tid();
    float* lds = (float*)(smem + VB * VB_LDS);
    unsigned char* ws = p.ws;
    prep_wt_units((bf16_t*)(ws + OFF_WT_IN), NIN, 1024, MapIn{p.in[1]}, lds, 2 * blockIdx.x + VB, 2 * gridDim.x);
    prep_wt_units((bf16_t*)(ws + OFF_WT_OUT), 1024, 2048, MapPlain{p.in[11], 1024}, lds, 2 * blockIdx.x + VB, 2 * gridDim.x);
    prep_wt_units((bf16_t*)(ws + OFF_WT_GU0), 5632, 1024, MapPair{p.in[14], p.in[15], FFH}, lds, 2 * blockIdx.x + VB, 2 * gridDim.x);
    prep_wt_units((bf16_t*)(ws + OFF_WT_DN0), 1024, 2816, MapPlain{p.in[16], 1024}, lds, 2 * blockIdx.x + VB, 2 * gridDim.x);
    for (int e = blockIdx.x * NT + T_; e < 64 * 64; e += gridDim.x * NT) {
        const int pp = e & 63, g = e >> 6, q = pp >> 5, lr = pp & 31;
        const float step = __expf(p.in[21][g]);
        const float ar = p.in[19][e], ai = p.in[20][e];
        const float mag = expf(ar * step);
        float sn, cs; sincosf(ai * step, &sn, &cs);
        const float abr = mag * cs, abi = mag * sn;
        float* ab = (float*)(ws + OFF_S5AB); ab[e * 2] = abr; ab[e * 2 + 1] = abi;
        const float nr = abr - 1.f, den = ar * ar + ai * ai;
        const float fr = (nr * ar + abi * ai) / den, fi = (abi * ar - nr * ai) / den;
        bf16_t* bb = (bf16_t*)(ws + OFF_S5BB);
        for (int c = 0; c < 16; ++c) {
            const float br = p.in[22][(size_t)e * 16 + c], bi = p.in[23][(size_t)e * 16 + c];
            const int lh = c >> 3, j = c & 7;
            bb[((((size_t)g * 4 + 2 * q) * 2 + lh) * 32 + lr) * 8 + j] = f2bf(fr * br - fi * bi);
            bb[((((size_t)g * 4 + 2 * q + 1) * 2 + lh) * 32 + lr) * 8 + j] = f2bf(fr * bi + fi * br);
        }
    }
    for (int e = blockIdx.x * NT + T_; e < 64 * 4 * 4 * 16 * 8; e += gridDim.x * NT) {
        const int j = e & 7, c = (e >> 3) & 15, lq = (e >> 7) & 3, ks4 = (e >> 9) & 3, g = e >> 11;
        const int k = ks4 * 32 + lq * 8 + j, st = k >> 1, comp = k & 1;
        const float v = comp ? -p.in[25][(size_t)(g * 16 + c) * 64 + st] : p.in[24][(size_t)(g * 16 + c) * 64 + st];
        ((bf16_t*)(ws + OFF_S5CM))[e] = f2bf(v);
    }
    const float* x = p.in[0];
    bf16_t* xb = (bf16_t*)p.out;
    const size_t n8 = (size_t)M_ * 1024 / 8;
    for (size_t i = (size_t)blockIdx.x * NT + T_; i < n8; i += (size_t)gridDim.x * NT) {
        const f32x4 a = *(const f32x4*)(x + i * 8), b = *(const f32x4*)(x + i * 8 + 4);
        u32x4 v; v.x = pack2(a[0], a[1]); v.y = pack2(a[2], a[3]); v.z = pack2(b[0], b[1]); v.w = pack2(b[2], b[3]);
        *(u32x4*)(xb + i * 8) = v;
    }
}
DI void prep_w1(const Params& p, unsigned char* smem, int first_wg) {
    const int T_ = opaque_tid();
    if ((int)blockIdx.x < first_wg) return;
    const int vb0 = 2 * ((int)blockIdx.x - first_wg) + VB, nvb = 2 * ((int)gridDim.x - first_wg);
    float* lds = (float*)(smem + VB * VB_LDS);
    unsigned char* ws = p.ws;
    prep_wt_units((bf16_t*)(ws + OFF_WT_GLU), 2048, 1024, MapPair{p.in[27], p.in[29], 1024}, lds, vb0, nvb);
    prep_wt_units((bf16_t*)(ws + OFF_WT_GU1), 5632, 1024, MapPair{p.in[33], p.in[34], FFH}, lds, vb0, nvb);
    prep_wt_units((bf16_t*)(ws + OFF_WT_DN1), 1024, 2816, MapPlain{p.in[35], 1024}, lds, vb0, nvb);
}

DI void phase_conv_gates(const Params& p, unsigned char* smem) {
    const int T_ = opaque_tid();
    unsigned char* ws = p.ws;
    const int tid = VTID;
    const float* conv_w = p.in[2]; const float* conv_b = p.in[3];
    bf16_t* xT = (bf16_t*)(ws + OFF_XT);
    const bf16_t* xhalo = (const bf16_t*)(ws + OFF_XHALO);
    constexpr int U1 = 4096, U2 = 512, U3 = 128, U4 = 2048;
    for (int u = 2 * blockIdx.x + VB; u < U1 + U2 + U3 + U4; u += 2 * gridDim.x) {
        if (u < U1) {
            const int chb = u & 31, tile = u >> 5, t0 = tile * 128;
            const int ch = chb * 32 + (tid & 31);
            u32x4 cur[2]; u32x2 prev[2];
#pragma unroll
            for (int i = 0; i < 2; ++i) {
                const int seg = (tid >> 5) + 8 * i;
                cur[i] = *(const u32x4*)(xT + tidx(ch, t0 + seg * 8));
                prev[i].x = 0; prev[i].y = 0;
                if (seg > 0) prev[i] = *(const u32x2*)(xT + tidx(ch, t0 + seg * 8 - 8) + 4);
                else if ((tile & 63) != 0) prev[i] = *(const u32x2*)(xhalo + ((size_t)(tile - 1) * 1024 + ch) * 4);
            }
            __syncthreads();
            const float w0 = conv_w[ch], w1 = conv_w[1536 + ch], w2 = conv_w[2 * 1536 + ch], w3 = conv_w[3 * 1536 + ch], bb = conv_b[ch];
#pragma unroll
            for (int i = 0; i < 2; ++i) {
                const int seg = (tid >> 5) + 8 * i;
                float xv[11];
                xv[0] = bfhi(prev[i].x); xv[1] = bflo(prev[i].y); xv[2] = bfhi(prev[i].y);
                xv[3] = bflo(cur[i].x); xv[4] = bfhi(cur[i].x); xv[5] = bflo(cur[i].y); xv[6] = bfhi(cur[i].y); xv[7] = bflo(cur[i].z); xv[8] = bfhi(cur[i].z); xv[9] = bflo(cur[i].w); xv[10] = bfhi(cur[i].w);
                float o[8];
#pragma unroll
                for (int e = 0; e < 8; ++e) o[e] = siluf_(bb + w0 * xv[e] + w1 * xv[e + 1] + w2 * xv[e + 2] + w3 * xv[e + 3]);
                u32x4 ov; ov.x = pack2(o[0], o[1]); ov.y = pack2(o[2], o[3]); ov.z = pack2(o[4], o[5]); ov.w = pack2(o[6], o[7]);
                *(u32x4*)(xT + tidx(ch, t0 + seg * 8)) = ov;
            }
        } else if (u < U1 + U2) {
            const int uu = u - U1, tile = uu >> 2, cblk = uu & 3, t0 = tile * 128;
            const int seg = tid >> 4, cg = tid & 15, cb = cblk * 128 + cg * 8;
            bf16_t* arr = (bf16_t*)(ws + (cb < 256 ? OFF_BTM : OFF_CTM));
            const int col = cb & 255;
            const bf16_t* bchalo = (const bf16_t*)(ws + OFF_BCHALO);
            u32x4 rows[11];
#pragma unroll
            for (int i = 0; i < 11; ++i) {
                const int tl = seg * 8 - 3 + i;
                if (tl >= 0) rows[i] = *(const u32x4*)(arr + (size_t)(t0 + tl) * 256 + col);
                else if ((tile & 63) != 0) rows[i] = *(const u32x4*)(bchalo + ((size_t)(tile - 1) * 4 + (4 + tl)) * 512 + cb);
                else { rows[i].x = 0; rows[i].y = 0; rows[i].z = 0; rows[i].w = 0; }
            }
            __syncthreads();
            u32x4 outr[8];
#pragma unroll
            for (int c2 = 0; c2 < 4; ++c2) {
                float wv[2][4], bv[2];
#pragma unroll
                for (int e = 0; e < 2; ++e) { const int cc = 1024 + cb + c2 * 2 + e; bv[e] = conv_b[cc];
#pragma unroll
                    for (int k = 0; k < 4; ++k) wv[e][k] = conv_w[k * 1536 + cc]; }
#pragma unroll
                for (int t = 0; t < 8; ++t) {
                    float o2[2];
#pragma unroll
                    for (int e = 0; e < 2; ++e) {
                        float s = bv[e];
#pragma unroll
                        for (int k = 0; k < 4; ++k) { const unsigned wd = rows[t + k][c2]; s += wv[e][k] * (e ? bfhi(wd) : bflo(wd)); }
                        o2[e] = siluf_(s);
                    }
                    outr[t][c2] = pack2(o2[0], o2[1]);
                }
            }
#pragma unroll
            for (int t = 0; t < 8; ++t) *(u32x4*)(arr + (size_t)(t0 + seg * 8 + t) * 256 + col) = outr[t];
            if (cb < 256) {
                bf16_t* BT = (bf16_t*)(ws + OFF_BT);
#pragma unroll
                for (int c = 0; c < 8; ++c) {
                    u32x4 v;
#pragma unroll
                    for (int tp = 0; tp < 4; ++tp) {
                        const unsigned lo = (outr[2 * tp][c >> 1] >> (16 * (c & 1))) & 0xffffu, hi = (outr[2 * tp + 1][c >> 1] >> (16 * (c & 1))) & 0xffffu;
                        v[tp] = lo | (hi << 16);
                    }
                    *(u32x4*)(BT + tidx(col + c, t0 + seg * 8)) = v;
                }
            }
        } else if (u < U1 + U2 + U3) {
            const int cc = u - U1 - U2, t0 = cc * 128;
            const int h = tid & 15, seg = tid >> 4;
            float* lds = (float*)(smem + VB * VB_LDS);
            const float* dt = (const float*)(ws + OFF_DT);
            float* dac = (float*)(ws + OFF_DAC); float* wst = (float*)(ws + OFF_WST); float* ssq = (float*)(ws + OFF_SSQ); float* cdec = (float*)(ws + OFF_CDEC);
            const float A = -__expf(p.in[5][h]);
            float dtv[8], cum[8]; float run = 0.f;
#pragma unroll
            for (int i = 0; i < 8; ++i) { dtv[i] = dt[(size_t)(t0 + seg * 8 + i) * 16 + h]; run += dtv[i] * A; cum[i] = run; }
            __syncthreads();
            lds[seg * 16 + h] = run;
            __syncthreads();
            float pre = 0.f, tot = 0.f;
            for (int s2 = 0; s2 < 16; ++s2) { const float v = lds[s2 * 16 + h]; if (s2 < seg) pre += v; tot += v; }
#pragma unroll
            for (int i = 0; i < 8; ++i) {
                const float c = pre + cum[i];
                dac[(size_t)(t0 + seg * 8 + i) * 16 + h] = c;
                wst[(size_t)h * M_ + t0 + seg * 8 + i] = dtv[i] * __expf(tot - c);
            }
            if (seg == 0) cdec[cc * 16 + h] = __expf(tot);
            if (tid < 128) ssq[t0 + tid] = 0.f;
        } else {
            const int uu = u - U1 - U2 - U3, cc = uu >> 4, cb = uu & 15, t0 = cc * 128;
            const int ch = cb * 32 + (tid & 31), seg = tid >> 5;
            float* lds = (float*)(smem + VB * VB_LDS);
            const float* ga = (const float*)(ws + OFF_GA);
            __syncthreads();
            for (int i = tid; i < 128 * 16; i += NTHREADS) lds[i] = ga[(size_t)t0 * 16 + i];
            __syncthreads();
            float wg[16];
#pragma unroll
            for (int r = 0; r < 16; ++r) wg[r] = p.in[8][r * 512 + ch];
            const float bg = p.in[9][ch];
            float la[16], run = 0.f;
#pragma unroll
            for (int i = 0; i < 16; ++i) {
                const int t = seg * 16 + i;
                float xg = bg;
#pragma unroll
                for (int r = 0; r < 16; ++r) xg += lds[t * 16 + r] * wg[r];
                la[i] = (fminf(xg, 0.f) - __logf(1.f + __expf(-fabsf(xg)))) * (1.f / 16.f);
                run += la[i];
            }
            lds[2048 + seg * 32 + (tid & 31)] = run;
            __syncthreads();
            float pre = 0.f, Gref = 0.f, Glast = 0.f;
#pragma unroll
            for (int s2 = 0; s2 < 8; ++s2) { const float v = lds[2048 + s2 * 32 + (tid & 31)]; if (s2 < seg) pre += v; if (s2 < 4) Gref += v; Glast += v; }
            if (seg == 0) {
                ((float*)(ws + OFF_GREF))[cc * 512 + ch] = __expf(Gref);
                ((float*)(ws + OFF_GLAST))[cc * 512 + ch] = __expf(Glast);
                ((float*)(ws + OFF_CSC))[cc * 512 + ch] = __expf(Glast - Gref);
            }
            bf16_t* q = (bf16_t*)(ws + OFF_Q); bf16_t* k = (bf16_t*)(ws + OFF_K); bf16_t* kT = (bf16_t*)(ws + OFF_KT);
            float G = pre, kk[16];
#pragma unroll
            for (int i = 0; i < 16; ++i) {
                G += la[i];
                const size_t idx = (size_t)(t0 + seg * 16 + i) * 512 + ch;
                const float qv = bf2f(q[idx]) * __expf(G - Gref);
                kk[i] = bf2f(k[idx]) * __expf(Gref - G);
                q[idx] = f2bf(qv); k[idx] = f2bf(kk[i]);
            }
            u32x4 v0, v1;
            v0.x = pack2(kk[0], kk[1]); v0.y = pack2(kk[2], kk[3]); v0.z = pack2(kk[4], kk[5]); v0.w = pack2(kk[6], kk[7]);
            v1.x = pack2(kk[8], kk[9]); v1.y = pack2(kk[10], kk[11]); v1.z = pack2(kk[12], kk[13]); v1.w = pack2(kk[14], kk[15]);
            *(u32x4*)(kT + tidx(ch, t0 + seg * 16)) = v0; *(u32x4*)(kT + tidx(ch, t0 + seg * 16 + 8)) = v1;
        }
    }
}

DI void phase_states(const Params& p) {
    const int T_ = opaque_tid();
    unsigned char* ws = p.ws;
    const int tid = VTID, lane = tid & 63, w = tid >> 6, lr = lane & 31, lh = lane >> 5;
    const bf16_t* xT = (const bf16_t*)(ws + OFF_XT); const bf16_t* BT = (const bf16_t*)(ws + OFF_BT);
    const float* wst = (const float*)(ws + OFF_WST);
    const bf16_t* vT = (const bf16_t*)(ws + OFF_VT); const bf16_t* kT = (const bf16_t*)(ws + OFF_KT);
    bf16_t* sst = (bf16_t*)p.out;
    bf16_t* gst = (bf16_t*)((unsigned char*)p.out + OUT_HALF);
    constexpr int U1 = 2048, U2 = 1024;
    for (int u = 2 * blockIdx.x + VB; u < U1 + U2; u += 2 * gridDim.x) {
        if (u < U1) {
            const int h = u & 15, cc = u >> 4, g = h >> 3, t0 = cc * 128;
            f32x16 acc[2] = {zero16(), zero16()};
#pragma unroll
            for (int ks = 0; ks < 8; ++ks) {
                const int tk = t0 + ks * 16 + 8 * lh;
                const bf16x8 b = ld_frag(BT + tidx(g * 128 + w * 32 + lr, tk));
                const f32x4 s0 = *(const f32x4*)(wst + (size_t)h * M_ + tk), s1 = *(const f32x4*)(wst + (size_t)h * M_ + tk + 4);
#pragma unroll
                for (int mi = 0; mi < 2; ++mi) {
                    const u32x4 xa = *(const u32x4*)(xT + tidx(h * 64 + mi * 32 + lr, tk));
                    u32x4 xs;
                    xs.x = pack2(bflo(xa.x) * s0[0], bfhi(xa.x) * s0[1]); xs.y = pack2(bflo(xa.y) * s0[2], bfhi(xa.y) * s0[3]);
                    xs.z = pack2(bflo(xa.z) * s1[0], bfhi(xa.z) * s1[1]); xs.w = pack2(bflo(xa.w) * s1[2], bfhi(xa.w) * s1[3]);
                    acc[mi] = MFMA(b, as_bf16x8(xs), acc[mi]);
                }
            }
            bf16_t* dst = sst + (size_t)(cc * 16 + h) * 64 * 128;
#pragma unroll
            for (int mi = 0; mi < 2; ++mi)
#pragma unroll
                for (int gq = 0; gq < 4; ++gq) { u32x2 v; v.x = pack2(acc[mi][4 * gq], acc[mi][4 * gq + 1]); v.y = pack2(acc[mi][4 * gq + 2], acc[mi][4 * gq + 3]);
                    *(u32x2*)(dst + sidx2(mi * 32 + lr, w * 32 + 8 * gq + 4 * lh)) = v; }
        } else {
            const int uu = u - U1, vh = uu & 1, hd = (uu >> 1) & 3, cc = uu >> 3, t0 = cc * 128;
            f32x16 acc[4] = {zero16(), zero16(), zero16(), zero16()};
            const int vrow = hd * 256 + vh * 128 + w * 32;
#pragma unroll
            for (int ks = 0; ks < 8; ++ks) {
                const int tk = t0 + ks * 16 + 8 * lh;
                const bf16x8 a = ld_frag(vT + tidx(vrow + lr, tk));
#pragma unroll
                for (int ni = 0; ni < 4; ++ni) {
                    const bf16x8 b = ld_frag(kT + tidx(hd * 128 + ni * 32 + lr, tk));
                    acc[ni] = MFMA(b, a, acc[ni]);
                }
            }
            bf16_t* dst = gst + (size_t)(cc * 4 + hd) * 256 * 128;
#pragma unroll
            for (int ni = 0; ni < 4; ++ni)
#pragma unroll
                for (int gq = 0; gq < 4; ++gq) { u32x2 v; v.x = pack2(acc[ni][4 * gq], acc[ni][4 * gq + 1]); v.y = pack2(acc[ni][4 * gq + 2], acc[ni][4 * gq + 3]);
                    *(u32x2*)(dst + sidx2(vh * 128 + w * 32 + lr, ni * 32 + 8 * gq + 4 * lh)) = v; }
        }
    }
}

DI void phase_carry(const Params& p) {
    const int T_ = opaque_tid();
    unsigned char* ws = p.ws;
    unsigned* sst = (unsigned*)p.out;
    unsigned* gst = (unsigned*)((unsigned char*)p.out + OUT_HALF);
    const float* cdec = (const float*)(ws + OFF_CDEC);
    const float* gref = (const float*)(ws + OFF_GREF); const float* glast = (const float*)(ws + OFF_GLAST); const float* csc = (const float*)(ws + OFF_CSC);
    constexpr int NE = 131072;
    for (int e = blockIdx.x * NT + T_; e < 2 * NE; e += gridDim.x * NT) {
        if (e < NE) {
            const int m = e & 4095, h = (e >> 12) & 15, b = e >> 16;
            float a0 = 0.f, a1 = 0.f;
#pragma unroll 8
            for (int c = 0; c < 64; ++c) {
                const int cc = b * 64 + c;
                unsigned* ptr = sst + (size_t)(cc * 16 + h) * 4096 + m;
                const unsigned s = *ptr;
                *ptr = pack2(a0, a1);
                const float d = cdec[cc * 16 + h];
                a0 = d * a0 + bflo(s); a1 = d * a1 + bfhi(s);
            }
        } else {
            const int e2 = e - NE;
            const int m = e2 & 16383, hd = (e2 >> 14) & 3, b = e2 >> 16;
            const int off = 2 * m, dd = ((off >> 9) & 7) * 16 + ((off >> 8) & 1) * 8 + (off & 7);
            float a0 = 0.f, a1 = 0.f;
#pragma unroll 8
            for (int c = 0; c < 64; ++c) {
                const int cc = b * 64 + c;
                unsigned* ptr = gst + (size_t)(cc * 4 + hd) * 16384 + m;
                const unsigned s = *ptr;
                const int fi = cc * 512 + hd * 128 + dd;
                *ptr = pack2(a0 * gref[fi], a1 * gref[fi + 1]);
                a0 = glast[fi] * a0 + csc[fi] * bflo(s); a1 = glast[fi + 1] * a1 + csc[fi + 1] * bfhi(s);
            }
        }
    }
}

DI void phase_mixer_out(const Params& p, unsigned char* smem) {
    const int T_ = opaque_tid();
    unsigned char* ws = p.ws;
    float* lds = (float*)(smem + VB * VB_LDS);
    const bf16_t* xT = (const bf16_t*)(ws + OFF_XT); const bf16_t* btm = (const bf16_t*)(ws + OFF_BTM); const bf16_t* ctm = (const bf16_t*)(ws + OFF_CTM);
    const float* dtp = (const float*)(ws + OFF_DT); const float* dac = (const float*)(ws + OFF_DAC);
    float* ssq = (float*)(ws + OFF_SSQ);
    bf16_t* zb = (bf16_t*)(ws + OFF_Z); bf16_t* rb = (bf16_t*)(ws + OFF_R);
    const bf16_t* qtm = (const bf16_t*)(ws + OFF_Q); const bf16_t* ktm = (const bf16_t*)(ws + OFF_K); const bf16_t* vT = (const bf16_t*)(ws + OFF_VT);
    const bf16_t* sst = (const bf16_t*)p.out;
    const bf16_t* gst = (const bf16_t*)((const unsigned char*)p.out + OUT_HALF);
    constexpr int U1 = 512, U2 = 1024;
    for (int u = 2 * blockIdx.x + VB; u < U1 + U2; u += 2 * gridDim.x) {
        int tid = VTID;
        asm volatile("" : "+v"(tid));
        const int lane = tid & 63, w = __builtin_amdgcn_readfirstlane(tid >> 6), lr = lane & 31, lh = lane >> 5;
#ifndef NO_SSD
        if (u < U1) {
            const int hq = u & 1, g = (u >> 1) & 1, cc = u >> 2, t0 = cc * 128;
            __syncthreads();
            for (int i = tid; i < 1024; i += NTHREADS) {
                const int tok = i >> 3, hh = i & 7;
                lds[i] = dac[(size_t)(t0 + tok) * 16 + g * 8 + hh];
                lds[1024 + i] = dtp[(size_t)(t0 + tok) * 16 + g * 8 + hh];
            }
            __syncthreads();
            const bf16_t* cp = ctm + (size_t)(t0 + w * 32 + lr) * 256 + g * 128 + 8 * lh;
            bf16x8 cf[8];
#pragma unroll
            for (int ks = 0; ks < 8; ++ks) cf[ks] = ld_frag(cp + ks * 16);
            float ssq_acc[16];
#pragma unroll
            for (int r = 0; r < 16; ++r) ssq_acc[r] = 0.f;
#pragma unroll 1
            for (int hh = hq * 4; hh < hq * 4 + 4; ++hh) {
                const int h = g * 8 + hh;
                f32x16 acc[2] = {zero16(), zero16()};
                const bf16_t* hent = sst + (size_t)(cc * 16 + h) * 64 * 128;
#pragma unroll
                for (int ks = 0; ks < 8; ++ks) {
#pragma unroll
                    for (int ni = 0; ni < 2; ++ni)
                        acc[ni] = MFMA(cf[ks], ld_frag(hent + sidx2(ni * 32 + lr, ks * 16 + 8 * lh)), acc[ni]);
                }
#pragma unroll
                for (int r = 0; r < 16; ++r) {
                    const float e = __expf(lds[(w * 32 + crow(r, lh)) * 8 + hh]);
                    acc[0][r] *= e; acc[1][r] *= e;
                }
                const float dAi = lds[(w * 32 + lr) * 8 + hh];
#pragma unroll 1
                for (int jt = 0; jt <= w; ++jt) {
                    const bf16_t* bp = btm + (size_t)(t0 + jt * 32 + lr) * 256 + g * 128 + 8 * lh;
                    bf16x8 bfr[8];
#pragma unroll
                    for (int ks = 0; ks < 8; ++ks) bfr[ks] = ld_frag(bp + ks * 16);
                    bf16x8 xf[2][2];
#pragma unroll
                    for (int s = 0; s < 2; ++s)
#pragma unroll
                        for (int ni = 0; ni < 2; ++ni) {
                            const int xch = h * 64 + ni * 32 + lr, xt = t0 + jt * 32 + 16 * s;
                            xf[s][ni] = ld_frag2(xT + tidx(xch, xt) + 4 * lh, xT + tidx(xch, xt + 8) + 4 * lh);
                        }
                    f32x16 ST = zero16();
#pragma unroll
                    for (int ks = 0; ks < 8; ++ks) ST = MFMA(bfr[ks], cf[ks], ST);
#pragma unroll
                    for (int r = 0; r < 16; ++r) {
                        const int jl = crow(r, lh), j = jt * 32 + jl;
                        const float v = ST[r] * __expf(dAi - lds[j * 8 + hh]) * lds[1024 + j * 8 + hh];
                        ST[r] = (jt < w || jl <= lr) ? v : 0.f;
                    }
#pragma unroll
                    for (int s = 0; s < 2; ++s) {
                        const bf16x8 af = pack_step(ST, s);
#pragma unroll
                        for (int ni = 0; ni < 2; ++ni) acc[ni] = MFMA(af, xf[s][ni], acc[ni]);
                    }
                }
                __builtin_amdgcn_sched_barrier(0);
                const float Dh = p.in[6][h];
#pragma unroll
                for (int ni = 0; ni < 2; ++ni) {
                    __builtin_amdgcn_sched_barrier(0);
                    const int ch = h * 64 + ni * 32 + lr;
                    const float gn = p.in[7][ch];
#pragma unroll
                    for (int rg = 0; rg < 4; ++rg) {
                        const int tb = t0 + w * 32 + 8 * rg + 4 * lh;
                        const u32x2 xv = *(const u32x2*)(xT + tidx(ch, tb));
                        const float xs[4] = {bflo(xv.x), bfhi(xv.x), bflo(xv.y), bfhi(xv.y)};
#pragma unroll
                        for (int e = 0; e < 4; ++e) {
                            const int r = 4 * rg + e;
                            const size_t zi = (size_t)(tb + e) * 1024 + ch;
                            float y = acc[ni][r] + Dh * xs[e];
                            y *= siluf_(bf2f(zb[zi]));
                            ssq_acc[r] += y * y;
                            zb[zi] = f2bf(y * gn);
                        }
                    }
                }
            }
#pragma unroll
            for (int r = 0; r < 16; ++r) {
                const float v = half_reduce(ssq_acc[r]);
                if (lr == 0) atomicAdd(ssq + t0 + w * 32 + crow(r, lh), v);
            }
        }
#endif
#ifndef NO_GLA
        if (u >= U1) {
            const int uu = u - U1, half = (uu ^ (uu >> 9)) & 1, hd = (uu >> 1) & 3, cc = uu >> 3, t0 = cc * 128;
            const int rt = 2 * half + (w >> 1), vh = w & 1;
            bf16x8 qf[8];
#pragma unroll
            for (int ks = 0; ks < 8; ++ks) qf[ks] = ld_frag(qtm + (size_t)(t0 + rt * 32 + lr) * 512 + hd * 128 + ks * 16 + 8 * lh);
            f32x16 o[4] = {zero16(), zero16(), zero16(), zero16()};
            const bf16_t* sent = gst + (size_t)(cc * 4 + hd) * 256 * 128;
#pragma unroll
            for (int ks = 0; ks < 8; ++ks)
#pragma unroll
                for (int ni = 0; ni < 4; ++ni)
                    o[ni] = MFMA(qf[ks], ld_frag(sent + sidx2(vh * 128 + ni * 32 + lr, ks * 16 + 8 * lh)), o[ni]);
#pragma unroll 1
            for (int jt = 0; jt <= rt; ++jt) {
                f32x16 ST = zero16();
                const bf16_t* kp = ktm + (size_t)(t0 + jt * 32 + lr) * 512 + hd * 128 + 8 * lh;
#pragma unroll
                for (int ks = 0; ks < 8; ++ks) ST = MFMA(ld_frag(kp + ks * 16), qf[ks], ST);
                if (jt == rt) {
#pragma unroll
                    for (int r = 0; r < 16; ++r) ST[r] = (crow(r, lh) <= lr) ? ST[r] : 0.f;
                }
#pragma unroll
                for (int s = 0; s < 2; ++s) {
                    const bf16x8 af = pack_step(ST, s);
#pragma unroll
                    for (int ni = 0; ni < 4; ++ni) {
                        const int vch = hd * 256 + vh * 128 + ni * 32 + lr, vt = t0 + jt * 32 + 16 * s;
                        o[ni] = MFMA(af, ld_frag2(vT + tidx(vch, vt) + 4 * lh, vT + tidx(vch, vt + 8) + 4 * lh), o[ni]);
                    }
                }
            }
            float ss[16];
#pragma unroll
            for (int r = 0; r < 16; ++r) {
                float v = 0.f;
#pragma unroll
                for (int ni = 0; ni < 4; ++ni) v += o[ni][r] * o[ni][r];
                ss[r] = half_reduce(v);
            }
            __syncthreads();
            if (lr == 0) {
#pragma unroll
                for (int r = 0; r < 16; ++r) lds[w * 32 + lh * 16 + r] = ss[r];
            }
            __syncthreads();
#pragma unroll
            for (int r = 0; r < 16; ++r) ss[r] = rsqrtf((ss[r] + lds[(w ^ 1) * 32 + lh * 16 + r]) * (1.f / 256.f) + LN_EPS);
#pragma unroll
            for (int ni = 0; ni < 4; ++ni) {
                const int ch = hd * 256 + vh * 128 + ni * 32 + lr;
                const float gn = p.in[10][ch];
#pragma unroll
                for (int r = 0; r < 16; ++r) {
                    const size_t ri = (size_t)(t0 + rt * 32 + crow(r, lh)) * 1024 + ch;
                    rb[ri] = f2bf(o[ni][r] * ss[r] * gn * siluf_(bf2f(rb[ri])));
                }
            }
        }
#endif
    }
}

DI void phase_ln(const float* src, float* dst, bf16_t* dstb, const float* g, const float* b) {
    const int T_ = opaque_tid();
    const int lane = T_ & 63, w = T_ >> 6;
    for (int r8 = blockIdx.x; r8 < M_ / 8; r8 += gridDim.x) {
        const int row = r8 * 8 + w;
        const float* s = src + (size_t)row * 1024;
        f32x4 v[4];
        float sum = 0.f;
#pragma unroll
        for (int i = 0; i < 4; ++i) { v[i] = *(const f32x4*)(s + i * 256 + lane * 4); sum += v[i][0] + v[i][1] + v[i][2] + v[i][3]; }
        sum = half_reduce(sum); sum += __shfl_xor(sum, 32);
        const float mu = sum * (1.f / 1024.f);
        float sq = 0.f;
#pragma unroll
        for (int i = 0; i < 4; ++i)
#pragma unroll
            for (int e = 0; e < 4; ++e) { const float d = v[i][e] - mu; sq += d * d; }
        sq = half_reduce(sq); sq += __shfl_xor(sq, 32);
        const float rs = rsqrtf(sq * (1.f / 1024.f) + LN_EPS);
#pragma unroll
        for (int i = 0; i < 4; ++i) {
            const int c = i * 256 + lane * 4;
            const f32x4 gv = *(const f32x4*)(g + c), bv = *(const f32x4*)(b + c);
            f32x4 o;
#pragma unroll
            for (int e = 0; e < 4; ++e) o[e] = (v[i][e] - mu) * rs * gv[e] + bv[e];
            *(f32x4*)(dst + (size_t)row * 1024 + c) = o;
            if (dstb) { u32x2 pk; pk.x = pack2(o[0], o[1]); pk.y = pack2(o[2], o[3]); *(u32x2*)(dstb + (size_t)row * 1024 + c) = pk; }
        }
    }
}

struct S5Lane { float abr[2], abi[2]; bf16x8 bfrag[4]; };
DI void s5_setup(const unsigned char* ws, int g, int lr, int lh, S5Lane& L) {
    const float* ab = (const float*)(ws + OFF_S5AB);
#pragma unroll
    for (int q = 0; q < 2; ++q) { L.abr[q] = ab[(g * 64 + 32 * q + lr) * 2]; L.abi[q] = ab[(g * 64 + 32 * q + lr) * 2 + 1]; }
#pragma unroll
    for (int nt = 0; nt < 4; ++nt) L.bfrag[nt] = ld_frag((const bf16_t*)(ws + OFF_S5BB) + ((((size_t)g * 4 + nt) * 2 + lh) * 32 + lr) * 8);
}
DI int s5_row_token(int pr, int tile, int r) { return (2 * pr + ((r >> 2) & 1)) * S5CH + tile * 16 + 4 * (r >> 3) + (r & 3); }

DI void phase_s5_local(const Params& p) {
    const int T_ = opaque_tid();
    unsigned char* ws = p.ws;
    const int tid = T_, lane = tid & 63, w = tid >> 6, lr = lane & 31, lh = lane >> 5;
    const bf16_t* xb = (const bf16_t*)p.out;
    float* sloc = (float*)(ws + OFF_SLOC);
    for (int bu = blockIdx.x; bu < (S5NCH / 2) * 64 / 8; bu += gridDim.x) {
        const int wu = bu * 8 + w, g = wu & 63, pr = wu >> 6;
        S5Lane L; s5_setup(ws, g, lr, lh, L);
        float cr[2] = {0.f, 0.f}, ci[2] = {0.f, 0.f};
#pragma unroll 2
        for (int tile = 0; tile < S5CH / 16; ++tile) {
            const bf16x8 a = ld_frag(xb + (size_t)s5_row_token(pr, tile, lr) * 1024 + g * 16 + 8 * lh);
            f32x16 buv[4];
#pragma unroll
            for (int nt = 0; nt < 4; ++nt) buv[nt] = MFMA(a, L.bfrag[nt], zero16());
#pragma unroll
            for (int q = 0; q < 2; ++q) {
                const float ar = L.abr[q], ai = L.abi[q];
                float sr = cr[q], si = ci[q];
#pragma unroll
                for (int i = 0; i < 16; ++i) { const float nr = ar * sr - ai * si + buv[2 * q][i], ni = ar * si + ai * sr + buv[2 * q + 1][i]; sr = nr; si = ni; }
                cr[q] = sr; ci[q] = si;
            }
        }
        const int ck = 2 * pr + lh;
#pragma unroll
        for (int q = 0; q < 2; ++q) { float* d = sloc + ((size_t)(ck * 64 + g) * 64 + 32 * q + lr) * 2; d[0] = cr[q]; d[1] = ci[q]; }
    }
}
DI void phase_s5_carry(const Params& p) {
    const int T_ = opaque_tid();
    unsigned char* ws = p.ws;
    const float* sloc = (const float*)(ws + OFF_SLOC); float* sent = (float*)(ws + OFF_SENT);
    for (int e = blockIdx.x * NT + T_; e < 8192; e += gridDim.x * NT) {
        const int pp = e & 63, g = (e >> 6) & 63, b = e >> 12;
        const float step = __expf(p.in[21][g]);
        const float ar = p.in[19][g * 64 + pp], ai = p.in[20][g * 64 + pp];
        const float mag = expf(ar * step);
        float sn, cs; sincosf(ai * step, &sn, &cs);
        float tr = mag * cs, ti = mag * sn;
        for (int i = 0; i < 7; ++i) { const float nr = tr * tr - ti * ti, ni = 2.f * tr * ti; tr = nr; ti = ni; }
        static_assert(S5CH == 128, "squaring count");
        float sr = 0.f, si = 0.f;
        typedef float f32x2_ __attribute__((ext_vector_type(2)));
        const f32x2_* __restrict__ sl2 = (const f32x2_*)sloc;
        f32x2_* __restrict__ se2 = (f32x2_*)sent;
#pragma unroll 1
        for (int kb = 0; kb < S5CPB; kb += 16) {
            f32x2_ lv[16];
#pragma unroll
            for (int i = 0; i < 16; ++i) lv[i] = sl2[(size_t)((b * S5CPB + kb + i) * 64 + g) * 64 + pp];
#pragma unroll
            for (int i = 0; i < 16; ++i) {
                f32x2_ o; o.x = sr; o.y = si;
                se2[(size_t)((b * S5CPB + kb + i) * 64 + g) * 64 + pp] = o;
                const float nr = tr * sr - ti * si + lv[i].x, ni = tr * si + ti * sr + lv[i].y;
                sr = nr; si = ni;
            }
        }
    }
}
DI void phase_s5_out(const Params& p, unsigned char* smem) {
    const int T_ = opaque_tid();
    unsigned char* ws = p.ws;
    const int tid = T_, lane = tid & 63, w = tid >> 6, lr = lane & 31, lh = lane >> 5;
    const bf16_t* xb = (const bf16_t*)p.out;
    bf16_t* yb = (bf16_t*)((unsigned char*)p.out + OUT_HALF);
    const float* xf = (const float*)(ws + OFF_U);
    const float* sent = (const float*)(ws + OFF_SENT);
    constexpr int SROW = 136;
    bf16_t* sl = (bf16_t*)smem + w * 32 * SROW;
    unsigned* sl32 = (unsigned*)sl;
    for (int bu = blockIdx.x; bu < (S5NCH / 2) * 64 / 8; bu += gridDim.x) {
        const int wu = bu * 8 + w, g = wu & 63, pr = wu >> 6;
        S5Lane L; s5_setup(ws, g, lr, lh, L);
        bf16x8 cfr[4];
#pragma unroll
        for (int ks = 0; ks < 4; ++ks) cfr[ks] = ld_frag((const bf16_t*)(ws + OFF_S5CM) + (((size_t)g * 4 + ks) * 64 + lane) * 8);
        const int ck = 2 * pr + lh;
        float cr[2], ci[2];
#pragma unroll
        for (int q = 0; q < 2; ++q) { const float* s0 = sent + ((size_t)(ck * 64 + g) * 64 + 32 * q + lr) * 2; cr[q] = s0[0]; ci[q] = s0[1]; }
        const int ch = g * 16 + (lane & 15);
        const float Dv = p.in[26][ch];
        bf16x8 a_nxt = ld_frag(xb + (size_t)s5_row_token(pr, 0, lr) * 1024 + g * 16 + 8 * lh);
#pragma unroll 1
        for (int tile = 0; tile < S5CH / 16; ++tile) {
            const bf16x8 a = a_nxt;
            if (tile + 1 < S5CH / 16) a_nxt = ld_frag(xb + (size_t)s5_row_token(pr, tile + 1, lr) * 1024 + g * 16 + 8 * lh);
            f32x16 buv[4];
#pragma unroll
            for (int nt = 0; nt < 4; ++nt) buv[nt] = MFMA(a, L.bfrag[nt], zero16());
            asm volatile("s_waitcnt lgkmcnt(0)" ::: "memory");
#pragma unroll
            for (int q = 0; q < 2; ++q) {
                const float ar = L.abr[q], ai = L.abi[q];
                float sr = cr[q], si = ci[q];
#pragma unroll
                for (int i = 0; i < 16; ++i) {
                    const float nr = ar * sr - ai * si + buv[2 * q][i], ni = ar * si + ai * sr + buv[2 * q + 1][i]; sr = nr; si = ni;
                    sl32[(16 * lh + i) * (SROW / 2) + 32 * q + lr] = pack2(sr, si);
                }
                cr[q] = sr; ci[q] = si;
            }
            asm volatile("s_waitcnt lgkmcnt(0)" ::: "memory");
#pragma unroll
            for (int t16 = 0; t16 < 2; ++t16) {
                f32x4 y = {0.f, 0.f, 0.f, 0.f};
#pragma unroll
                for (int ks = 0; ks < 4; ++ks)
                    y = __builtin_amdgcn_mfma_f32_16x16x32_bf16(ld_frag(sl + (t16 * 16 + (lane & 15)) * SROW + ks * 32 + 8 * (lane >> 4)), cfr[ks], y, 0, 0, 0);
#pragma unroll
                for (int r = 0; r < 4; ++r) {
                    const size_t idx = (size_t)((2 * pr + t16) * S5CH + tile * 16 + (lane >> 4) * 4 + r) * 1024 + ch;
                    yb[idx] = f2bf(gelu_tanh(y[r] + Dv * xf[idx]));
                }
            }
        }
    }
}

#define XB_TMO      128
#define XB_XCNT(j)  (256  + 64 * (j))
#define XB_XSUB(j)  (1280 + 64 * (j))
#define XB_XGEN(j)  (2304 + 64 * (j))
#define XB_TOP      3328
#define XB_TOPGEN   3392
#define XCD_BAR_WORDS 3456
#define XB_SPIN_CAP (1u << 18)
#define LAS __attribute__((address_space(3)))

__device__ __forceinline__ unsigned xb_ld(unsigned* p)              { return __hip_atomic_load(p, __ATOMIC_RELAXED, __HIP_MEMORY_SCOPE_AGENT); }
__device__ __forceinline__ unsigned xb_add(unsigned* p, unsigned v) { return __hip_atomic_fetch_add(p, v, __ATOMIC_RELAXED, __HIP_MEMORY_SCOPE_AGENT); }
__device__ __forceinline__ unsigned xb_xcc_id() { return (unsigned)__builtin_amdgcn_s_getreg((3 << 11) | 20) & 0xFu; }
#define XB_SPIN(cond, bar) do { unsigned _sp = 0; while (cond) { __builtin_amdgcn_s_sleep(1); \
    if ((++_sp & 255u) == 0u) { if (xb_ld(&(bar)[XB_TMO])) break; if (_sp > XB_SPIN_CAP) { atomicAdd(&(bar)[XB_TMO], 1u); break; } } } } while (0)

struct XcdBarrier {
    unsigned* bar; unsigned x;
    volatile LAS unsigned* st;
};

__device__ __forceinline__ XcdBarrier xcd_barrier_post(unsigned* bar, volatile LAS unsigned* st) {
    XcdBarrier b; b.bar = bar; b.x = xb_xcc_id(); b.st = st;
    if (threadIdx.x == 0) (void)xb_add(&bar[XB_XCNT(b.x)], 1u);
    return b;
}
__device__ __forceinline__ void xcd_barrier_complete(unsigned* bar, unsigned x, unsigned& nloc, unsigned& nx) {
    const unsigned G = gridDim.x * gridDim.y * gridDim.z;
    unsigned sum, cnt, mine, sp = 0u;
    for (;;) {
        sum = 0u; cnt = 0u; mine = 0u;
#pragma unroll
        for (unsigned j = 0; j < 16; ++j) { const unsigned c = xb_ld(&bar[XB_XCNT(j)]); sum += c; cnt += (c > 0u) ? 1u : 0u; mine = (j == x) ? c : mine; }
        if (sum == G) break;
        __builtin_amdgcn_s_sleep(1);
        if ((++sp & 255u) == 0u) { if (xb_ld(&bar[XB_TMO])) break; if (sp > XB_SPIN_CAP) { atomicAdd(&bar[XB_TMO], 1u); break; } }
    }
    nloc = mine > 0u ? mine : 1u; nx = cnt > 0u ? cnt : 1u;
}

__device__ __forceinline__ void xcd_barrier(const XcdBarrier& b) {
    asm volatile("s_waitcnt vmcnt(0)" ::: "memory");
    __syncthreads();
    if (threadIdx.x == 0) {
        unsigned* bar = b.bar;
        unsigned bx_ = b.x;
        asm volatile("" : "+s"(bx_));
        __builtin_amdgcn_s_waitcnt(0);
        unsigned nloc = b.st[0], nx = b.st[1];
        if (nloc == 0u) { xcd_barrier_complete(bar, bx_, nloc, nx); b.st[0] = nloc; b.st[1] = nx; }
        const unsigned old = xb_add(&bar[XB_XSUB(bx_)], 1u);
        const unsigned gen = old / nloc;
        if (old + 1u == (gen + 1u) * nloc) {
            __builtin_amdgcn_fence(__ATOMIC_RELEASE, "agent");
            asm volatile("s_waitcnt vmcnt(0)" ::: "memory");
            const unsigned og = xb_add(&bar[XB_TOP], 1u);
            const unsigned tg = og / nx;
            if (og + 1u == (tg + 1u) * nx) xb_add(&bar[XB_TOPGEN], 1u);
            else XB_SPIN(xb_ld(&bar[XB_TOPGEN]) == tg, bar);
            __builtin_amdgcn_fence(__ATOMIC_ACQUIRE, "agent");
            xb_add(&bar[XB_XGEN(bx_)], 1u);
            asm volatile("s_waitcnt vmcnt(0)" ::: "memory");
        } else {
            XB_SPIN(xb_ld(&bar[XB_XGEN(bx_)]) == gen, bar);
            __builtin_amdgcn_fence(__ATOMIC_ACQUIRE, "agent");
            asm volatile("s_waitcnt vmcnt(0)" ::: "memory");
        }
    }
    __syncthreads();
}


constexpr int NPHASE = 19;
#ifdef ONLY_PHASE
#define PEN(n) ((n) == ONLY_PHASE)
#else
#define PEN(n) true
#endif
__global__ void __launch_bounds__(NT) mega(Params p) {
    __builtin_assume(__builtin_amdgcn_workitem_id_y() == 0);
    __builtin_assume(__builtin_amdgcn_workitem_id_z() == 0);
    extern __shared__ __attribute__((aligned(16))) unsigned char smem[];
    cg::grid_group grid = cg::this_grid();
    unsigned char* ws = p.ws;
    float* U = (float*)(ws + OFF_U);
    bf16_t* xb = (bf16_t*)p.out;
    bf16_t* yb = (bf16_t*)((unsigned char*)p.out + OUT_HALF);
    bf16_t* hmid = (bf16_t*)(ws + OFF_HMID);
    bf16_t* shm = (bf16_t*)smem;
    volatile LAS unsigned* xst = (volatile LAS unsigned*)(smem + g8::SHM_B);
    if (threadIdx.x < 2) xst[threadIdx.x] = 0u;
    __syncthreads();
    const XcdBarrier gbar = xcd_barrier_post((unsigned*)(ws + OFF_BAR), xst);
#ifndef DUP
#define DUP 0
#endif
#define PHASE_BEGIN(n) for (int rep_ = 0; rep_ < (((DUP) >> (n)) & 1) + 1; ++rep_) { if (PEN(n)) {
#define PHASE_END }  xcd_barrier(gbar); }
    if (PEN(0)) phase_prep0(p, smem);
    if (p.ph_hi) grid.sync();
    xcd_barrier(gbar);
    PHASE_BEGIN(1)
        EpiInProj e{(bf16_t*)(ws + OFF_Z), (bf16_t*)(ws + OFF_XT), (bf16_t*)(ws + OFF_BTM), (bf16_t*)(ws + OFF_CTM), (bf16_t*)(ws + OFF_Q), (bf16_t*)(ws + OFF_K),
                    (bf16_t*)(ws + OFF_VT), (bf16_t*)(ws + OFF_R), (bf16_t*)(ws + OFF_XHALO), (bf16_t*)(ws + OFF_BCHALO), (float*)(ws + OFF_DT), (float*)(ws + OFF_GA), p.in[4]};
        g8::phase(xb, 1024, (const bf16_t*)(ws + OFF_WT_IN), 1024, 1024, M_, NIN, shm, e);
    PHASE_END
    PHASE_BEGIN(2) phase_conv_gates(p, smem); PHASE_END
    PHASE_BEGIN(3) phase_states(p); PHASE_END
    PHASE_BEGIN(4) phase_carry(p); PHASE_END
    PHASE_BEGIN(5) phase_mixer_out(p, smem); PHASE_END
    PHASE_BEGIN(6)
        EpiResidual<0> e0{U, p.in[0], nullptr};
        g8::phase((const bf16_t*)(ws + OFF_R), 1024, (const bf16_t*)(ws + OFF_WT_OUT) + 1024, 2048, 1024, M_, 1024, shm, e0);
        EpiResidual<1> e1{U, nullptr, (const float*)(ws + OFF_SSQ)};
        g8::phase((const bf16_t*)(ws + OFF_Z), 1024, (const bf16_t*)(ws + OFF_WT_OUT), 2048, 1024, M_, 1024, shm, e1);
    PHASE_END
    PHASE_BEGIN(7) phase_ln(U, U, xb, p.in[12], p.in[13]); PHASE_END
    PHASE_BEGIN(8) EpiSwiGLU e{hmid}; g8::phase(xb, 1024, (const bf16_t*)(ws + OFF_WT_GU0), 1024, 1024, M_, 5632, shm, e);
        __syncthreads();
        prep_w1(p, smem, (int)gridDim.x == 256 ? 128 : 0);
    PHASE_END
    PHASE_BEGIN(9) EpiResidual<0> e{U, U, nullptr}; g8::phase(hmid, FFH, (const bf16_t*)(ws + OFF_WT_DN0), FFH, FFH, M_, 1024, shm, e); PHASE_END
    PHASE_BEGIN(10) phase_ln(U, U, xb, p.in[17], p.in[18]); PHASE_END
    PHASE_BEGIN(11) phase_s5_local(p); PHASE_END
    PHASE_BEGIN(12) phase_s5_carry(p); PHASE_END
    PHASE_BEGIN(13) phase_s5_out(p, smem); PHASE_END
    PHASE_BEGIN(14) EpiGLU e{U, p.in[28], p.in[30]}; g8::phase(yb, 1024, (const bf16_t*)(ws + OFF_WT_GLU), 1024, 1024, M_, 2048, shm, e); PHASE_END
    PHASE_BEGIN(15) phase_ln(U, U, xb, p.in[31], p.in[32]); PHASE_END
    PHASE_BEGIN(16) EpiSwiGLU e{hmid}; g8::phase(xb, 1024, (const bf16_t*)(ws + OFF_WT_GU1), 1024, 1024, M_, 5632, shm, e); PHASE_END
    PHASE_BEGIN(17) EpiResidual<0> e{U, U, nullptr}; g8::phase(hmid, FFH, (const bf16_t*)(ws + OFF_WT_DN1), FFH, FFH, M_, 1024, shm, e); PHASE_END
    if (PEN(18)) phase_ln(U, p.out, nullptr, p.in[36], p.in[37]);
}

extern "C" void kernel_launch(void* const* d_in, const int* in_sizes, int n_in, void* d_out, int out_size, void* d_ws, size_t ws_size, hipStream_t stream) {
    static int grid_blocks = 0;
    constexpr size_t kDynLds = g8::SHM_B + 16;
    if (grid_blocks == 0) {
        if (n_in != 38 || out_size != M_ * D_ || ws_size < WS_TOTAL) { fprintf(stderr, "kernel_launch: unexpected shapes (n_in %d out %d ws %zu need %zu)\n", n_in, out_size, ws_size, (size_t)WS_TOTAL); grid_blocks = -1; return; }
        int dev = 0, cus = 0, per_cu = 0;
        (void)hipGetDevice(&dev);
        (void)hipDeviceGetAttribute(&cus, hipDeviceAttributeMultiprocessorCount, dev);
        if (hipFuncSetAttribute((const void*)mega, hipFuncAttributeMaxDynamicSharedMemorySize, (int)kDynLds) != hipSuccess) { fprintf(stderr, "hipFuncSetAttribute failed\n"); (void)hipGetLastError(); }
        if (hipOccupancyMaxActiveBlocksPerMultiprocessor(&per_cu, (const void*)mega, NT, kDynLds) != hipSuccess || per_cu < 1) { fprintf(stderr, "occupancy query failed (%d)\n", per_cu); (void)hipGetLastError(); per_cu = 1; }
        grid_blocks = cus;
        (void)per_cu;
    }
    if (grid_blocks < 0) return;
    if (hipMemsetAsync((unsigned char*)d_ws + OFF_BAR, 0, 3456 * 4, stream) != hipSuccess) { fprintf(stderr, "barrier memset failed\n"); return; }
    Params p{};
    for (int i = 0; i < 38; ++i) p.in[i] = (const float*)d_in[i];
    p.out = (float*)d_out; p.ws = (unsigned char*)d_ws; p.ph_lo = 0; p.ph_hi = 0;
    void* args[] = {&p};
    hipError_t e = hipLaunchCooperativeKernel((const void*)mega, dim3(grid_blocks), dim3(NT), args, kDynLds, stream);
    if (e != hipSuccess) fprintf(stderr, "cooperative launch failed: %s (grid %d)\n", hipGetErrorString(e), grid_blocks);
}
```

```cpp
#include <hip/hip_runtime.h>
#include <hip/hip_cooperative_groups.h>
#include <cstdio>
#include <cstdint>
namespace cg = cooperative_groups;

#define DI __device__ __forceinline__
typedef unsigned short bf16_t;
typedef short bf16x8 __attribute__((ext_vector_type(8)));
typedef float f32x16 __attribute__((ext_vector_type(16)));
typedef float f32x4 __attribute__((ext_vector_type(4)));
typedef unsigned u32x4 __attribute__((ext_vector_type(4)));
typedef unsigned u32x2 __attribute__((ext_vector_type(2)));

#define MFMA(a, b, c) __builtin_amdgcn_mfma_f32_32x32x16_bf16((a), (b), (c), 0, 0, 0)

constexpr int M_ = 16384, D_ = 1024, L_ = 8192;
constexpr int NTHREADS = 256;
constexpr int NT = 512;
constexpr int VB_LDS = 36864;
#define VB (T_ >> 8)
#define VTID (T_ & 255)
__device__ __forceinline__ int opaque_tid() { int t = threadIdx.x; asm volatile("" : "+v"(t)); return t; }
constexpr float DN_ALPHA = 1.4142135623730951f;
constexpr float LN_EPS = 1e-5f;
constexpr int FFH = 2816;
constexpr int NIN = 5888;

constexpr size_t SZ_WT_IN = (size_t)NIN * 1024 * 2;
constexpr size_t SZ_WT_OUT = (size_t)1024 * 2048 * 2;
constexpr size_t SZ_WT_GU = (size_t)5632 * 1024 * 2;
constexpr size_t SZ_WT_DN = (size_t)1024 * 2816 * 2;
constexpr size_t SZ_WT_GLU = (size_t)2048 * 1024 * 2;
constexpr size_t OFF_WT_IN = 0;
constexpr size_t OFF_WT_OUT = OFF_WT_IN + SZ_WT_IN;
constexpr size_t OFF_WT_GU0 = OFF_WT_OUT + SZ_WT_OUT;
constexpr size_t OFF_WT_DN0 = OFF_WT_GU0 + SZ_WT_GU;
constexpr size_t OFF_U = OFF_WT_DN0 + SZ_WT_DN;
constexpr size_t SZ_U = (size_t)M_ * 1024 * 4;
constexpr size_t OFF_XT = OFF_U;
constexpr size_t OFF_BTM = OFF_XT + (size_t)1024 * M_ * 2;
constexpr size_t OFF_CTM = OFF_BTM + (size_t)M_ * 256 * 2;
constexpr size_t OFF_BT = OFF_CTM + (size_t)M_ * 256 * 2;
constexpr size_t OFF_H = OFF_U + SZ_U;
constexpr size_t SZ_H = (size_t)M_ * 3584 * 2;
constexpr size_t OFF_Z = OFF_H;
constexpr size_t OFF_R = OFF_Z + (size_t)M_ * 1024 * 2;
constexpr size_t OFF_Q = OFF_R + (size_t)M_ * 1024 * 2;
constexpr size_t OFF_K = OFF_Q + (size_t)M_ * 512 * 2;
constexpr size_t OFF_KT = OFF_K + (size_t)M_ * 512 * 2;
constexpr size_t OFF_HMID = OFF_H;
constexpr size_t OFF_W1 = OFF_H + (size_t)M_ * 2816 * 2;
constexpr size_t OFF_WT_GLU = OFF_W1;
constexpr size_t OFF_WT_GU1 = OFF_WT_GLU + SZ_WT_GLU;
constexpr size_t OFF_WT_DN1 = OFF_WT_GU1 + SZ_WT_GU;
static_assert(OFF_WT_DN1 + SZ_WT_DN <= OFF_H + SZ_H, "W1 must fit in H tail");
constexpr size_t OFF_SLOC = OFF_H;
constexpr int S5CH = 128, S5NCH = M_ / S5CH, S5CPB = L_ / S5CH, S5TILES = S5CH / 32;
constexpr size_t OFF_SENT = OFF_SLOC + (size_t)256 * 64 * 64 * 2 * 4;
constexpr size_t OFF_VT = OFF_H + SZ_H;
constexpr size_t OFF_SM = OFF_VT + (size_t)1024 * M_ * 2;
constexpr size_t OFF_DT = OFF_SM;
constexpr size_t OFF_GA = OFF_DT + (size_t)M_ * 16 * 4;
constexpr size_t OFF_DAC = OFF_GA + (size_t)M_ * 16 * 4;
constexpr size_t OFF_WST = OFF_DAC + (size_t)M_ * 16 * 4;
constexpr size_t OFF_SSQ = OFF_WST + (size_t)M_ * 16 * 4;
constexpr size_t OFF_XHALO = OFF_SSQ + (size_t)M_ * 4;
constexpr size_t OFF_BCHALO = OFF_XHALO + (size_t)128 * 1024 * 4 * 2;
constexpr size_t OFF_CDEC = OFF_BCHALO + (size_t)128 * 4 * 512 * 2;
constexpr size_t OFF_GREF = OFF_CDEC + (size_t)128 * 16 * 4;
constexpr size_t OFF_GLAST = OFF_GREF + (size_t)128 * 512 * 4;
constexpr size_t OFF_CSC = OFF_GLAST + (size_t)128 * 512 * 4;
constexpr size_t WS_END = OFF_CSC + (size_t)128 * 512 * 4;
constexpr size_t OFF_S5AB = (WS_END + 255) & ~(size_t)255;
constexpr size_t OFF_S5BB = OFF_S5AB + (size_t)64 * 64 * 2 * 4;
constexpr size_t OFF_S5CM = OFF_S5BB + (size_t)64 * 4 * 2 * 32 * 8 * 2;
constexpr size_t OFF_BAR = OFF_S5CM + (size_t)64 * 8 * 2 * 32 * 8 * 2;
constexpr size_t WS_TOTAL = OFF_BAR + 3456 * 4;
static_assert(WS_TOTAL <= (size_t)256 * 1024 * 1024, "workspace overflow");
constexpr size_t OUT_HALF = (size_t)M_ * 1024 * 2;

struct Params {
    const float* in[38];
    float* out;
    unsigned char* ws;
    int ph_lo, ph_hi;
};

typedef __bf16 hwbf2 __attribute__((ext_vector_type(2)));
typedef float f32x2h __attribute__((ext_vector_type(2)));
DI bf16_t f2bf(float x) { return __builtin_bit_cast(bf16_t, (__bf16)x); }
DI float bf2f(bf16_t b) { return __uint_as_float(((unsigned)b) << 16); }
DI unsigned pack2(float a, float b) { f32x2h v; v.x = a; v.y = b; return __builtin_bit_cast(unsigned, __builtin_convertvector(v, hwbf2)); }
DI float bflo(unsigned u) { return __uint_as_float(u << 16); }
DI float bfhi(unsigned u) { return __uint_as_float(u & 0xffff0000u); }
DI int crow(int reg, int h) { return (reg & 3) + 8 * (reg >> 2) + 4 * h; }
DI size_t tidx(int ch, int tok) { return ((((size_t)(ch >> 5) * (M_ / 16) + (tok >> 4)) * 2 + ((tok >> 3) & 1)) * 32 + (ch & 31)) * 8 + (tok & 7); }
DI int sidx2(int row, int k) { return ((((row >> 5) * 8 + (k >> 4)) * 2 + ((k >> 3) & 1)) * 32 + (row & 31)) * 8 + (k & 7); }
DI float sigmoidf_(float x) { return __builtin_amdgcn_rcpf(1.f + __expf(-x)); }
DI float siluf_(float x) { return x * sigmoidf_(x); }
DI float softplusf_(float x) { return fmaxf(x, 0.f) + log1pf(__expf(-fabsf(x))); }
DI float logsigmoidf_(float x) { return fminf(x, 0.f) - log1pf(__expf(-fabsf(x))); }
DI float gelu_tanh(float y) { const float t = 0.7978845608028654f * (y + 0.044715f * y * y * y); const float th = 1.f - 2.f * __builtin_amdgcn_rcpf(__expf(2.f * t) + 1.f); return 0.5f * y * (1.f + th); }
DI bf16x8 as_bf16x8(u32x4 v) { return __builtin_bit_cast(bf16x8, v); }
DI bf16x8 ld_frag(const bf16_t* p) { return as_bf16x8(*(const u32x4*)p); }
DI bf16x8 ld_frag2(const bf16_t* p0, const bf16_t* p1) { u32x2 a = *(const u32x2*)p0, b = *(const u32x2*)p1; u32x4 v; v.x = a.x; v.y = a.y; v.z = b.x; v.w = b.y; return as_bf16x8(v); }
DI f32x16 zero16() { f32x16 z; for (int i = 0; i < 16; ++i) z[i] = 0.f; return z; }
DI bf16x8 pack_step(const f32x16& x, int s) { u32x4 v; v.x = pack2(x[8 * s], x[8 * s + 1]); v.y = pack2(x[8 * s + 2], x[8 * s + 3]); v.z = pack2(x[8 * s + 4], x[8 * s + 5]); v.w = pack2(x[8 * s + 6], x[8 * s + 7]); return as_bf16x8(v); }
DI float half_reduce(float v) {
    v += __shfl_xor(v, 1); v += __shfl_xor(v, 2); v += __shfl_xor(v, 4); v += __shfl_xor(v, 8); v += __shfl_xor(v, 16); return v;
}

typedef float f32x4v __attribute__((ext_vector_type(4)));
namespace g8 {
constexpr int BM = 256, BKK = 64, HALF = 128, HT = HALF * BKK, SHM_B = 8 * HT * 2, NXCD = 8, WGM = 8;
DI int lds_byte(int r, int c) { const int st = (r >> 4) * 2 + (c >> 5), rr = r & 15, cc = c & 31, ob = rr * 64 + cc * 2; return st * 1024 + (ob ^ (((ob >> 9) & 1) << 5)); }
DI void stage_rc(int b, int& R, int& C) { const int st = b / 1024, sb = b % 1024, swz = sb ^ (((sb >> 9) & 1) << 5); R = (st >> 1) * 16 + swz / 64; C = (st & 1) * 32 + (swz % 64) / 2; }

template <class Epi>
DI void tile(const bf16_t* __restrict__ A, int lda, const bf16_t* __restrict__ Bt, int ldb, int K, int brow, int bcol, bool first, bool has_next, int nbrow, int nbcol, bf16_t* shm, const Epi& epi) {
#define SA(b, h) (shm + ((b) * 4 + (h)) * HT)
#define SB(b, h) (shm + ((b) * 4 + 2 + (h)) * HT)
#define STAGE(P, BASE, OFF, LD, br, kt) do { const bf16_t* _g = (BASE) + ((size_t)(br) * (LD) + (size_t)(kt) * BKK); \
    _Pragma("unroll") for (int _i = 0; _i < 2; ++_i) { \
      __builtin_amdgcn_global_load_lds((const unsigned*)(_g + OFF[_i]), (__attribute__((address_space(3))) unsigned*)((char*)(P) + tx * 16 + _i * 8192), 16, 0, 0); } } while (0)
#define LDA(dst, b, h) _Pragma("unroll") for (int m = 0; m < 4; ++m) _Pragma("unroll") for (int k = 0; k < 2; ++k) \
    dst[m][k] = *reinterpret_cast<const bf16x8*>((char*)SA(b, h) + lds_byte(wr * 64 + m * 16 + fr, k * 32 + fq * 8))
#define LDB(dst, b, h) _Pragma("unroll") for (int n = 0; n < 2; ++n) _Pragma("unroll") for (int k = 0; k < 2; ++k) \
    dst[n][k] = *reinterpret_cast<const bf16x8*>((char*)SB(b, h) + lds_byte(wc * 32 + n * 16 + fr, k * 32 + fq * 8))
#define MMA(ai, bj, At_, Bt_) do { __builtin_amdgcn_s_setprio(1); \
    _Pragma("unroll") for (int m = 0; m < 4; ++m) _Pragma("unroll") for (int n = 0; n < 2; ++n) _Pragma("unroll") for (int k = 0; k < 2; ++k) \
      acc[ai][bj][m][n] = __builtin_amdgcn_mfma_f32_16x16x32_bf16(At_[m][k], Bt_[n][k], acc[ai][bj][m][n], 0, 0, 0); \
    __builtin_amdgcn_s_setprio(0); } while (0)
#define WAIT_V(n) asm volatile("s_waitcnt vmcnt(" #n ")" ::: "memory")
#define WAIT_L(n) asm volatile("s_waitcnt lgkmcnt(" #n ")" ::: "memory")
#define BAR __builtin_amdgcn_s_barrier()
#define SCHED __builtin_amdgcn_sched_barrier(0)
    int tx = threadIdx.x;
    asm volatile("" : "+v"(tx));
    const int wid = tx >> 6, lane = tx & 63, wr = __builtin_amdgcn_readfirstlane(wid >> 2), wc = __builtin_amdgcn_readfirstlane(wid & 3), fr = lane & 15, fq = lane >> 4;
    unsigned offA[2], offB[2];
#pragma unroll
    for (int i = 0; i < 2; ++i) { int r_, c_; stage_rc(tx * 16 + i * 8192, r_, c_); offA[i] = (unsigned)(r_ * lda + c_); offB[i] = (unsigned)(r_ * ldb + c_); }
    f32x4v acc[2][2][4][2];
#pragma unroll
    for (int a = 0; a < 2; ++a)
#pragma unroll
        for (int b = 0; b < 2; ++b)
#pragma unroll
            for (int m = 0; m < 4; ++m)
#pragma unroll
                for (int n = 0; n < 2; ++n) acc[a][b][m][n] = (f32x4v){0.f, 0.f, 0.f, 0.f};
    bf16x8 At[4][2], B0[2][2], B1[2][2];
    const int nt = K / BKK;
    WAIT_V(0);
    if (first) {
        STAGE(SB(0, 0), Bt, offB, ldb, bcol, 0); STAGE(SA(0, 0), A, offA, lda, brow, 0);
        STAGE(SB(0, 1), Bt, offB, ldb, bcol + HALF, 0); STAGE(SA(0, 1), A, offA, lda, brow + HALF, 0);
    }
    if (wr == 1) BAR;
    if (first) WAIT_V(4);
    BAR;
    STAGE(SB(1, 0), Bt, offB, ldb, bcol, 1); STAGE(SA(1, 0), A, offA, lda, brow, 1); STAGE(SB(1, 1), Bt, offB, ldb, bcol + HALF, 1);
    WAIT_V(6); BAR;
#pragma unroll 1
    for (int t = 0; t < nt - 2; t += 2) {
        LDB(B0, 0, 0); SCHED; LDA(At, 0, 0); STAGE(SA(1, 1), A, offA, lda, brow + HALF, t + 1);
        WAIT_L(8); BAR; WAIT_L(0); MMA(0, 0, At, B0); BAR; SCHED;
        LDB(B1, 0, 1); STAGE(SB(0, 0), Bt, offB, ldb, bcol, t + 2);
        BAR; WAIT_L(0); MMA(0, 1, At, B1); BAR;
        LDA(At, 0, 1); STAGE(SA(0, 0), A, offA, lda, brow, t + 2);
        BAR; WAIT_L(0); MMA(1, 0, At, B0); BAR; SCHED;
        STAGE(SB(0, 1), Bt, offB, ldb, bcol + HALF, t + 2);
        WAIT_V(6); BAR; MMA(1, 1, At, B1); BAR;
        LDB(B0, 1, 0); SCHED; LDA(At, 1, 0); STAGE(SA(0, 1), A, offA, lda, brow + HALF, t + 2);
        WAIT_L(8); BAR; WAIT_L(0); MMA(0, 0, At, B0); BAR; SCHED;
        LDB(B1, 1, 1); STAGE(SB(1, 0), Bt, offB, ldb, bcol, t + 3);
        BAR; WAIT_L(0); MMA(0, 1, At, B1); BAR;
        LDA(At, 1, 1); STAGE(SA(1, 0), A, offA, lda, brow, t + 3);
        BAR; WAIT_L(0); MMA(1, 0, At, B0); BAR; SCHED;
        STAGE(SB(1, 1), Bt, offB, ldb, bcol + HALF, t + 3);
        WAIT_V(6); BAR; MMA(1, 1, At, B1); BAR;
    }
    { LDB(B0, 0, 0); LDA(At, 0, 0); STAGE(SA(1, 1), A, offA, lda, brow + HALF, nt - 1);
      BAR; WAIT_L(0); MMA(0, 0, At, B0); BAR;
      LDB(B1, 0, 1); BAR; WAIT_L(0); MMA(0, 1, At, B1); BAR;
      LDA(At, 0, 1); WAIT_V(4); BAR; WAIT_L(0); MMA(1, 0, At, B0); MMA(1, 1, At, B1); BAR; }
    { LDB(B0, 1, 0); LDA(At, 1, 0); WAIT_V(2); BAR; WAIT_L(0); MMA(0, 0, At, B0); BAR;
      LDB(B1, 1, 1); WAIT_V(0); BAR; WAIT_L(0); MMA(0, 1, At, B1); BAR;
      LDA(At, 1, 1); BAR; WAIT_L(0); MMA(1, 0, At, B0); MMA(1, 1, At, B1); BAR; }
    if (wr == 0) BAR;
    {
        int t2 = threadIdx.x;
        asm volatile("" : "+v"(t2));
        if (has_next) {
            unsigned oA[2], oB[2];
#pragma unroll
            for (int i = 0; i < 2; ++i) { int r_, c_; stage_rc(t2 * 16 + i * 8192, r_, c_); oA[i] = (unsigned)(r_ * lda + c_); oB[i] = (unsigned)(r_ * ldb + c_); }
            const int tx = t2;
            STAGE(SB(0, 0), Bt, oB, ldb, nbcol, 0); STAGE(SA(0, 0), A, oA, lda, nbrow, 0);
            STAGE(SB(0, 1), Bt, oB, ldb, nbcol + HALF, 0); STAGE(SA(0, 1), A, oA, lda, nbrow + HALF, 0);
        }
        float* stg = (float*)(shm + 4 * HT);
        const int wr2 = t2 >> 8, wc2 = (t2 >> 6) & 3, fr2 = t2 & 15, fq2 = (t2 >> 4) & 3;
#pragma unroll
        for (int q = 0; q < 4; ++q) {
            const int ai = q >> 1, bj = q & 1;
            typename Epi::Pre pre;
            epi.pre(pre, brow + ai * 128, bcol + bj * 128, t2);
#pragma unroll
            for (int m = 0; m < 4; ++m)
#pragma unroll
                for (int n = 0; n < 2; ++n)
#pragma unroll
                    for (int j = 0; j < 4; ++j)
                        stg[(wr2 * 64 + m * 16 + fq2 * 4 + j) * 128 + ((wc2 * 32 + n * 16 + fr2) ^ (fq2 << 4))] = acc[ai][bj][m][n][j];
            WAIT_L(0); BAR;
            epi.quarter(stg, brow + ai * 128, bcol + bj * 128, t2, pre);
            WAIT_L(0); BAR;
        }
    }
#undef SA
#undef SB
#undef STAGE
#undef LDA
#undef LDB
#undef MMA
#undef WAIT_V
#undef WAIT_L
#undef BAR
#undef SCHED
}

DI void tile_coords(int L, int nM, int nN, int& pm, int& pn) {
    const int nwg = nM * nN;
    int wgid = L;
    { const int q = nwg / NXCD, r = nwg % NXCD, xcd = wgid % NXCD, off = wgid / NXCD; wgid = (xcd < r ? xcd * (q + 1) : r * (q + 1) + (xcd - r) * q) + off; }
    const int nig = WGM * nN, gid = wgid / nig, fm = gid * WGM, gsz = (nM - fm) < WGM ? (nM - fm) : WGM;
    pm = fm + ((wgid % nig) % gsz); pn = (wgid % nig) / gsz;
}
template <class Epi>
DI void phase(const bf16_t* A, int lda, const bf16_t* Bt, int ldb, int K, int Mrows, int Ncols, bf16_t* shm, const Epi& epi) {
    const int nM = Mrows / BM, nN = Ncols / BM, nwg = nM * nN;
    bool first = true;
    for (int L = blockIdx.x; L < nwg; L += gridDim.x) {
        int pm, pn, qm = 0, qn = 0;
        tile_coords(L, nM, nN, pm, pn);
        const bool has_next = (L + (int)gridDim.x) < nwg;
        if (has_next) tile_coords(L + gridDim.x, nM, nN, qm, qn);
        tile(A, lda, Bt, ldb, K, pm * BM, pn * BM, first, has_next, qm * BM, qn * BM, shm, epi);
        first = false;
    }
    asm volatile("s_waitcnt vmcnt(0)" ::: "memory");
}
}

DI int sidx(int rl, int c) { return rl * 128 + (c ^ (((rl >> 2) & 3) << 4)); }
DI u32x4 pack8(const f32x4& a, const f32x4& b) { u32x4 v; v.x = pack2(a[0], a[1]); v.y = pack2(a[2], a[3]); v.z = pack2(b[0], b[1]); v.w = pack2(b[2], b[3]); return v; }
DI void quarter_store_bf16(const float* stg, bf16_t* dst, int ld, int r0, int cdst, float scale, int t) {
    const int c8 = (t & 15) * 8;
#pragma unroll 2
    for (int i = 0; i < 4; ++i) {
        const int rl = (t >> 4) + 32 * i;
        f32x4 a = *(const f32x4*)(stg + sidx(rl, c8)), b = *(const f32x4*)(stg + sidx(rl, c8 + 4));
        a *= scale; b *= scale;
        *(u32x4*)(dst + (size_t)(r0 + rl) * ld + cdst + c8) = pack8(a, b);
    }
}
DI void quarter_store_T(const float* stg, bf16_t* dstT, int ch0, int r0, bf16_t* halo, int t) {
    const int col = t & 127;
#pragma unroll 2
    for (int i = 0; i < 4; ++i) {
        const int r8 = (t >> 7) + 4 * i;
        float v[8];
#pragma unroll
        for (int jj = 0; jj < 8; ++jj) v[jj] = stg[sidx(8 * r8 + jj, col)];
        u32x4 pk; pk.x = pack2(v[0], v[1]); pk.y = pack2(v[2], v[3]); pk.z = pack2(v[4], v[5]); pk.w = pack2(v[6], v[7]);
        *(u32x4*)(dstT + tidx(ch0 + col, r0 + 8 * r8)) = pk;
        if (halo && r8 == 15) { u32x2 h; h.x = pk.z; h.y = pk.w; *(u32x2*)(halo + ((size_t)(r0 >> 7) * 1024 + ch0 + col) * 4) = h; }
    }
}
struct EpiInProj {
    struct Pre {}; DI void pre(Pre&, int, int, int) const {}
    bf16_t *z, *xT, *btm, *ctm, *q, *k, *vT, *r, *xhalo, *bchalo; float *dt, *ga; const float* dt_bias;
    DI void quarter(const float* stg, int r0, int c0, int t, const Pre& pre) const {
        if (c0 < 1024) quarter_store_bf16(stg, z, 1024, r0, c0, 1.f, t);
        else if (c0 < 2048) quarter_store_T(stg, xT, c0 - 1024, r0, xhalo, t);
        else if (c0 < 2560) {
            const int cb = c0 - 2048;
            quarter_store_bf16(stg, cb < 256 ? btm : ctm, 256, r0, cb & 255, 1.f, t);
            if (t < 64) {
                const int rl = 124 + (t >> 4), c8 = (t & 15) * 8;
                const f32x4 a = *(const f32x4*)(stg + sidx(rl, c8)), b = *(const f32x4*)(stg + sidx(rl, c8 + 4));
                *(u32x4*)(bchalo + ((size_t)(r0 >> 7) * 4 + (t >> 4)) * 512 + cb + c8) = pack8(a, b);
            }
        }
        else if (c0 < 3072) quarter_store_bf16(stg, q, 512, r0, c0 - 2560, 0.08838834764831845f, t);
        else if (c0 < 3584) quarter_store_bf16(stg, k, 512, r0, c0 - 3072, 1.f, t);
        else if (c0 < 4608) quarter_store_T(stg, vT, c0 - 3584, r0, nullptr, t);
        else if (c0 < 5632) quarter_store_bf16(stg, r, 1024, r0, c0 - 4608, 1.f, t);
        else if (c0 == 5632) {
            int tt = t;
            asm volatile("" : "+v"(tt));
            const int c = tt & 31;
            const float bias = c < 16 ? dt_bias[c] : 0.f;
#pragma unroll 2
            for (int i = 0; i < 8; ++i) {
                const int rl = (tt >> 5) + 16 * i;
                const float v = stg[sidx(rl, c)];
                if (c < 16) dt[(size_t)(r0 + rl) * 16 + c] = softplusf_(v + bias);
                else ga[(size_t)(r0 + rl) * 16 + c - 16] = v;
            }
        }
    }
};

template <int MODE>
struct EpiResidual {
    float* U; const float* X; const float* ssq;
    struct Pre { f32x4 x[4][2]; };
    DI void pre(Pre& P, int r0, int c0, int t) const {
        const float* src = (MODE == 0) ? X : U;
        const int c8 = (t & 15) * 8;
#pragma unroll
        for (int i = 0; i < 4; ++i) { const size_t idx = (size_t)(r0 + (t >> 4) + 32 * i) * 1024 + c0 + c8; P.x[i][0] = *(const f32x4*)(src + idx); P.x[i][1] = *(const f32x4*)(src + idx + 4); }
    }
    DI void quarter(const float* stg, int r0, int c0, int t, const Pre& pre) const {
        const int c8 = (t & 15) * 8;
#pragma unroll
        for (int i = 0; i < 4; ++i) {
            const int rl = (t >> 4) + 32 * i;
            const f32x4 a = *(const f32x4*)(stg + sidx(rl, c8)), b = *(const f32x4*)(stg + sidx(rl, c8 + 4));
            const size_t idx = (size_t)(r0 + rl) * 1024 + c0 + c8;
            if (MODE == 0) {
                const f32x4 xa = pre.x[i][0], xb2 = pre.x[i][1];
                *(f32x4*)(U + idx) = xa * DN_ALPHA + a; *(f32x4*)(U + idx + 4) = xb2 * DN_ALPHA + b;
            } else {
                const float sc = rsqrtf(ssq[r0 + rl] * (1.f / 1024.f) + LN_EPS);
                const f32x4 ua = pre.x[i][0], ub = pre.x[i][1];
                *(f32x4*)(U + idx) = ua + a * sc; *(f32x4*)(U + idx + 4) = ub + b * sc;
            }
        }
    }
};

struct EpiSwiGLU {
    struct Pre {}; DI void pre(Pre&, int, int, int) const {}
    bf16_t* hmid;
    DI void quarter(const float* stg, int r0, int c0, int t, const Pre& pre) const {
        const int u8 = (t & 7) * 8, cg = (u8 >> 4) * 32 + (u8 & 15);
#pragma unroll 1
        for (int i = 0; i < 2; ++i) {
            const int rl = (t >> 3) + 64 * i;
            const f32x4 g0 = *(const f32x4*)(stg + sidx(rl, cg)), g1 = *(const f32x4*)(stg + sidx(rl, cg + 4)), u0 = *(const f32x4*)(stg + sidx(rl, cg + 16)), u1 = *(const f32x4*)(stg + sidx(rl, cg + 20));
            f32x4 o0, o1;
#pragma unroll
            for (int e = 0; e < 4; ++e) { o0[e] = siluf_(g0[e]) * u0[e]; o1[e] = siluf_(g1[e]) * u1[e]; }
            *(u32x4*)(hmid + (size_t)(r0 + rl) * FFH + (c0 >> 1) + u8) = pack8(o0, o1);
        }
    }
};
struct EpiGLU {
    struct Pre { f32x4 u[2][2]; };
    DI void pre(Pre& P, int r0, int c0, int t) const {
        const int u8 = (t & 7) * 8, unit = (c0 >> 1) + u8;
#pragma unroll
        for (int i = 0; i < 2; ++i) { const size_t idx = (size_t)(r0 + (t >> 3) + 64 * i) * 1024 + unit; P.u[i][0] = *(const f32x4*)(U + idx); P.u[i][1] = *(const f32x4*)(U + idx + 4); }
    }
    float* U; const float *ba, *bb;
    DI void quarter(const float* stg, int r0, int c0, int t, const Pre& pre) const {
        const int u8 = (t & 7) * 8, cg = (u8 >> 4) * 32 + (u8 & 15);
        const int unit = (c0 >> 1) + u8;
        const f32x4 ba0 = *(const f32x4*)(ba + unit), ba1 = *(const f32x4*)(ba + unit + 4), bb0 = *(const f32x4*)(bb + unit), bb1 = *(const f32x4*)(bb + unit + 4);
#pragma unroll
        for (int i = 0; i < 2; ++i) {
            const int rl = (t >> 3) + 64 * i;
            const f32x4 a0 = *(const f32x4*)(stg + sidx(rl, cg)), a1 = *(const f32x4*)(stg + sidx(rl, cg + 4)), b0 = *(const f32x4*)(stg + sidx(rl, cg + 16)), b1 = *(const f32x4*)(stg + sidx(rl, cg + 20));
            const size_t idx = (size_t)(r0 + rl) * 1024 + unit;
            f32x4 o0 = pre.u[i][0], o1 = pre.u[i][1];
#pragma unroll
            for (int e = 0; e < 4; ++e) {
                o0[e] = DN_ALPHA * o0[e] + (a0[e] + ba0[e]) * sigmoidf_(b0[e] + bb0[e]);
                o1[e] = DN_ALPHA * o1[e] + (a1[e] + ba1[e]) * sigmoidf_(b1[e] + bb1[e]);
            }
            *(f32x4*)(U + idx) = o0; *(f32x4*)(U + idx + 4) = o1;
        }
    }
};

struct ColSrc { const float* p; int ld; };
template <class MapFn>
DI void prep_wt_units(bf16_t* dst, int Nd, int K, const MapFn& mapfn, float* lds, int vb0, int nvb) {
    const int T_ = opaque_tid();
    const int nkt = K / 64, nun = (Nd / 64) * nkt;
    const int tid = VTID;
    const int nn_l = tid & 63, kq_l = tid >> 6;
    float vals[16];
    int uu = vb0;
    if (uu < nun) {
        const int nt = uu / nkt, kt = uu % nkt;
        const ColSrc cs = mapfn(nt * 64 + nn_l);
#pragma unroll
        for (int i = 0; i < 16; ++i) vals[i] = cs.p ? cs.p[(size_t)(kt * 64 + i * 4 + kq_l) * cs.ld] : 0.f;
    }
    for (; uu < nun; uu += nvb) {
        const int nt = uu / nkt, kt = uu % nkt, n0 = nt * 64, k0 = kt * 64;
#pragma unroll
        for (int i = 0; i < 16; ++i) lds[(i * 4 + kq_l) * 65 + nn_l] = vals[i];
        __syncthreads();
        const int un = uu + nvb;
        if (un < nun) {
            const int nt2 = un / nkt, kt2 = un % nkt;
            const ColSrc cs = mapfn(nt2 * 64 + nn_l);
#pragma unroll
            for (int i = 0; i < 16; ++i) vals[i] = cs.p ? cs.p[(size_t)(kt2 * 64 + i * 4 + kq_l) * cs.ld] : 0.f;
        }
        {
            const int nn = tid >> 2, kq = tid & 3;
            u32x4 v0, v1;
            const float* sp = lds + (kq * 16) * 65 + nn;
            v0.x = pack2(sp[0 * 65], sp[1 * 65]); v0.y = pack2(sp[2 * 65], sp[3 * 65]); v0.z = pack2(sp[4 * 65], sp[5 * 65]); v0.w = pack2(sp[6 * 65], sp[7 * 65]);
            v1.x = pack2(sp[8 * 65], sp[9 * 65]); v1.y = pack2(sp[10 * 65], sp[11 * 65]); v1.z = pack2(sp[12 * 65], sp[13 * 65]); v1.w = pack2(sp[14 * 65], sp[15 * 65]);
            bf16_t* d = dst + (size_t)(n0 + nn) * K + k0 + kq * 16;
            *(u32x4*)d = v0; *(u32x4*)(d + 8) = v1;
        }
        __syncthreads();
    }
}

struct MapIn { const float* w;
    DI ColSrc operator()(int n) const {
        int src;
        if (n < 2560) src = n; else if (n < 3072) src = 2576 + (n - 2560); else if (n < 3584) src = 3088 + (n - 3072);
        else if (n < 4608) src = 3600 + (n - 3584); else if (n < 5632) src = 4624 + (n - 4608); else if (n < 5648) src = 2560 + (n - 5632);
        else if (n < 5664) src = n; else return ColSrc{nullptr, 0};
        return ColSrc{w + src, 5664};
    } };
struct MapPlain { const float* w; int ld; DI ColSrc operator()(int n) const { return ColSrc{w + n, ld}; } };
struct MapPair { const float *wa, *wb; int ld;
    DI ColSrc operator()(int n) const { const int unit = (n >> 5) * 16 + (n & 15); return ColSrc{((n >> 4) & 1) ? wb + unit : wa + unit, ld}; } };

DI void phase_prep0(const Params& p, unsigned char* smem) {
    const int T_ = opaque_tid();
    float* lds = (float*)(smem + VB * VB_LDS);
    unsigned char* ws = p.ws;
    prep_wt_units((bf16_t*)(ws + OFF_WT_IN), NIN, 1024, MapIn{p.in[1]}, lds, 2 * blockIdx.x + VB, 2 * gridDim.x);
    prep_wt_units((bf16_t*)(ws + OFF_WT_OUT), 1024, 2048, MapPlain{p.in[11], 1024}, lds, 2 * blockIdx.x + VB, 2 * gridDim.x);
    prep_wt_units((bf16_t*)(ws + OFF_WT_GU0), 5632, 1024, MapPair{p.in[14], p.in[15], FFH}, lds, 2 * blockIdx.x + VB, 2 * gridDim.x);
    prep_wt_units((bf16_t*)(ws + OFF_WT_DN0), 1024, 2816, MapPlain{p.in[16], 1024}, lds, 2 * blockIdx.x + VB, 2 * gridDim.x);
    for (int e = blockIdx.x * NT + T_; e < 64 * 64; e += gridDim.x * NT) {
        const int pp = e & 63, g = e >> 6, q = pp >> 5, lr = pp & 31;
        const float step = __expf(p.in[21][g]);
        const float ar = p.in[19][e], ai = p.in[20][e];
        const float mag = expf(ar * step);
        float sn, cs; sincosf(ai * step, &sn, &cs);
        const float abr = mag * cs, abi = mag * sn;
        float* ab = (float*)(ws + OFF_S5AB); ab[e * 2] = abr; ab[e * 2 + 1] = abi;
        const float nr = abr - 1.f, den = ar * ar + ai * ai;
        const float fr = (nr * ar + abi * ai) / den, fi = (abi * ar - nr * ai) / den;
        bf16_t* bb = (bf16_t*)(ws + OFF_S5BB);
        for (int c = 0; c < 16; ++c) {
            const float br = p.in[22][(size_t)e * 16 + c], bi = p.in[23][(size_t)e * 16 + c];
            const int lh = c >> 3, j = c & 7;
            bb[((((size_t)g * 4 + 2 * q) * 2 + lh) * 32 + lr) * 8 + j] = f2bf(fr * br - fi * bi);
            bb[((((size_t)g * 4 + 2 * q + 1) * 2 + lh) * 32 + lr) * 8 + j] = f2bf(fr * bi + fi * br);
        }
    }
    for (int e = blockIdx.x * NT + T_; e < 64 * 4 * 4 * 16 * 8; e += gridDim.x * NT) {
        const int j = e & 7, c = (e >> 3) & 15, lq = (e >> 7) & 3, ks4 = (e >> 9) & 3, g = e >> 11;
        const int k = ks4 * 32 + lq * 8 + j, st = k >> 1, comp = k & 1;
        const float v = comp ? -p.in[25][(size_t)(g * 16 + c) * 64 + st] : p.in[24][(size_t)(g * 16 + c) * 64 + st];
        ((bf16_t*)(ws + OFF_S5CM))[e] = f2bf(v);
    }
    const float* x = p.in[0];
    bf16_t* xb = (bf16_t*)p.out;
    const size_t n8 = (size_t)M_ * 1024 / 8;
    for (size_t i = (size_t)blockIdx.x * NT + T_; i < n8; i += (size_t)gridDim.x * NT) {
        const f32x4 a = *(const f32x4*)(x + i * 8), b = *(const f32x4*)(x + i * 8 + 4);
        u32x4 v; v.x = pack2(a[0], a[1]); v.y = pack2(a[2], a[3]); v.z = pack2(b[0], b[1]); v.w = pack2(b[2], b[3]);
        *(u32x4*)(xb + i * 8) = v;
    }
}
DI void prep_w1(const Params& p, unsigned char* smem, int first_wg) {
    const int T_ = opaque_tid();
    if ((int)blockIdx.x < first_wg) return;
    const int vb0 = 2 * ((int)blockIdx.x - first_wg) + VB, nvb = 2 * ((int)gridDim.x - first_wg);
    float* lds = (float*)(smem + VB * VB_LDS);
    unsigned char* ws = p.ws;
    prep_wt_units((bf16_t*)(ws + OFF_WT_GLU), 2048, 1024, MapPair{p.in[27], p.in[29], 1024}, lds, vb0, nvb);
    prep_wt_units((bf16_t*)(ws + OFF_WT_GU1), 5632, 1024, MapPair{p.in[33], p.in[34], FFH}, lds, vb0, nvb);
    prep_wt_units((bf16_t*)(ws + OFF_WT_DN1), 1024, 2816, MapPlain{p.in[35], 1024}, lds, vb0, nvb);
}

DI void phase_conv_gates(const Params& p, unsigned char* smem) {
    const int T_ = opaque_tid();
    unsigned char* ws = p.ws;
    const int tid = VTID;
    const float* conv_w = p.in[2]; const float* conv_b = p.in[3];
    bf16_t* xT = (bf16_t*)(ws + OFF_XT);
    const bf16_t* xhalo = (const bf16_t*)(ws + OFF_XHALO);
    constexpr int U1 = 4096, U2 = 512, U3 = 128, U4 = 2048;
    for (int u = 2 * blockIdx.x + VB; u < U1 + U2 + U3 + U4; u += 2 * gridDim.x) {
        if (u < U1) {
            const int chb = u & 31, tile = u >> 5, t0 = tile * 128;
            const int ch = chb * 32 + (tid & 31);
            u32x4 cur[2]; u32x2 prev[2];
#pragma unroll
            for (int i = 0; i < 2; ++i) {
                const int seg = (tid >> 5) + 8 * i;
                cur[i] = *(const u32x4*)(xT + tidx(ch, t0 + seg * 8));
                prev[i].x = 0; prev[i].y = 0;
                if (seg > 0) prev[i] = *(const u32x2*)(xT + tidx(ch, t0 + seg * 8 - 8) + 4);
                else if ((tile & 63) != 0) prev[i] = *(const u32x2*)(xhalo + ((size_t)(tile - 1) * 1024 + ch) * 4);
            }
            __syncthreads();
            const float w0 = conv_w[ch], w1 = conv_w[1536 + ch], w2 = conv_w[2 * 1536 + ch], w3 = conv_w[3 * 1536 + ch], bb = conv_b[ch];
#pragma unroll
            for (int i = 0; i < 2; ++i) {
                const int seg = (tid >> 5) + 8 * i;
                float xv[11];
                xv[0] = bfhi(prev[i].x); xv[1] = bflo(prev[i].y); xv[2] = bfhi(prev[i].y);
                xv[3] = bflo(cur[i].x); xv[4] = bfhi(cur[i].x); xv[5] = bflo(cur[i].y); xv[6] = bfhi(cur[i].y); xv[7] = bflo(cur[i].z); xv[8] = bfhi(cur[i].z); xv[9] = bflo(cur[i].w); xv[10] = bfhi(cur[i].w);
                float o[8];
#pragma unroll
                for (int e = 0; e < 8; ++e) o[e] = siluf_(bb + w0 * xv[e] + w1 * xv[e + 1] + w2 * xv[e + 2] + w3 * xv[e + 3]);
                u32x4 ov; ov.x = pack2(o[0], o[1]); ov.y = pack2(o[2], o[3]); ov.z = pack2(o[4], o[5]); ov.w = pack2(o[6], o[7]);
                *(u32x4*)(xT + tidx(ch, t0 + seg * 8)) = ov;
            }
        } else if (u < U1 + U2) {
            const int uu = u - U1, tile = uu >> 2, cblk = uu & 3, t0 = tile * 128;
            const int seg = tid >> 4, cg = tid & 15, cb = cblk * 128 + cg * 8;
            bf16_t* arr = (bf16_t*)(ws + (cb < 256 ? OFF_BTM : OFF_CTM));
            const int col = cb & 255;
            const bf16_t* bchalo = (const bf16_t*)(ws + OFF_BCHALO);
            u32x4 rows[11];
#pragma unroll
            for (int i = 0; i < 11; ++i) {
                const int tl = seg * 8 - 3 + i;
                if (tl >= 0) rows[i] = *(const u32x4*)(arr + (size_t)(t0 + tl) * 256 + col);
                else if ((tile & 63) != 0) rows[i] = *(const u32x4*)(bchalo + ((size_t)(tile - 1) * 4 + (4 + tl)) * 512 + cb);
                else { rows[i].x = 0; rows[i].y = 0; rows[i].z = 0; rows[i].w = 0; }
            }
            __syncthreads();
            u32x4 outr[8];
#pragma unroll
            for (int c2 = 0; c2 < 4; ++c2) {
                float wv[2][4], bv[2];
#pragma unroll
                for (int e = 0; e < 2; ++e) { const int cc = 1024 + cb + c2 * 2 + e; bv[e] = conv_b[cc];
#pragma unroll
                    for (int k = 0; k < 4; ++k) wv[e][k] = conv_w[k * 1536 + cc]; }
#pragma unroll
                for (int t = 0; t < 8; ++t) {
                    float o2[2];
#pragma unroll
                    for (int e = 0; e < 2; ++e) {
                        float s = bv[e];
#pragma unroll
                        for (int k = 0; k < 4; ++k) { const unsigned wd = rows[t + k][c2]; s += wv[e][k] * (e ? bfhi(wd) : bflo(wd)); }
                        o2[e] = siluf_(s);
                    }
                    outr[t][c2] = pack2(o2[0], o2[1]);
                }
            }
#pragma unroll
            for (int t = 0; t < 8; ++t) *(u32x4*)(arr + (size_t)(t0 + seg * 8 + t) * 256 + col) = outr[t];
            if (cb < 256) {
                bf16_t* BT = (bf16_t*)(ws + OFF_BT);
#pragma unroll
                for (int c = 0; c < 8; ++c) {
                    u32x4 v;
#pragma unroll
                    for (int tp = 0; tp < 4; ++tp) {
                        const unsigned lo = (outr[2 * tp][c >> 1] >> (16 * (c & 1))) & 0xffffu, hi = (outr[2 * tp + 1][c >> 1] >> (16 * (c & 1))) & 0xffffu;
                        v[tp] = lo | (hi << 16);
                    }
                    *(u32x4*)(BT + tidx(col + c, t0 + seg * 8)) = v;
                }
            }
        } else if (u < U1 + U2 + U3) {
            const int cc = u - U1 - U2, t0 = cc * 128;
            const int h = tid & 15, seg = tid >> 4;
            float* lds = (float*)(smem + VB * VB_LDS);
            const float* dt = (const float*)(ws + OFF_DT);
            float* dac = (float*)(ws + OFF_DAC); float* wst = (float*)(ws + OFF_WST); float* ssq = (float*)(ws + OFF_SSQ); float* cdec = (float*)(ws + OFF_CDEC);
            const float A = -__expf(p.in[5][h]);
            float dtv[8], cum[8]; float run = 0.f;
#pragma unroll
            for (int i = 0; i < 8; ++i) { dtv[i] = dt[(size_t)(t0 + seg * 8 + i) * 16 + h]; run += dtv[i] * A; cum[i] = run; }
            __syncthreads();
            lds[seg * 16 + h] = run;
            __syncthreads();
            float pre = 0.f, tot = 0.f;
            for (int s2 = 0; s2 < 16; ++s2) { const float v = lds[s2 * 16 + h]; if (s2 < seg) pre += v; tot += v; }
#pragma unroll
            for (int i = 0; i < 8; ++i) {
                const float c = pre + cum[i];
                dac[(size_t)(t0 + seg * 8 + i) * 16 + h] = c;
                wst[(size_t)h * M_ + t0 + seg * 8 + i] = dtv[i] * __expf(tot - c);
            }
            if (seg == 0) cdec[cc * 16 + h] = __expf(tot);
            if (tid < 128) ssq[t0 + tid] = 0.f;
        } else {
            const int uu = u - U1 - U2 - U3, cc = uu >> 4, cb = uu & 15, t0 = cc * 128;
            const int ch = cb * 32 + (tid & 31), seg = tid >> 5;
            float* lds = (float*)(smem + VB * VB_LDS);
            const float* ga = (const float*)(ws + OFF_GA);
            __syncthreads();
            for (int i = tid; i < 128 * 16; i += NTHREADS) lds[i] = ga[(size_t)t0 * 16 + i];
            __syncthreads();
            float wg[16];
#pragma unroll
            for (int r = 0; r < 16; ++r) wg[r] = p.in[8][r * 512 + ch];
            const float bg = p.in[9][ch];
            float la[16], run = 0.f;
#pragma unroll
            for (int i = 0; i < 16; ++i) {
                const int t = seg * 16 + i;
                float xg = bg;
#pragma unroll
                for (int r = 0; r < 16; ++r) xg += lds[t * 16 + r] * wg[r];
                la[i] = (fminf(xg, 0.f) - __logf(1.f + __expf(-fabsf(xg)))) * (1.f / 16.f);
                run += la[i];
            }
            lds[2048 + seg * 32 + (tid & 31)] = run;
            __syncthreads();
            float pre = 0.f, Gref = 0.f, Glast = 0.f;
#pragma unroll
            for (int s2 = 0; s2 < 8; ++s2) { const float v = lds[2048 + s2 * 32 + (tid & 31)]; if (s2 < seg) pre += v; if (s2 < 4) Gref += v; Glast += v; }
            if (seg == 0) {
                ((float*)(ws + OFF_GREF))[cc * 512 + ch] = __expf(Gref);
                ((float*)(ws + OFF_GLAST))[cc * 512 + ch] = __expf(Glast);
                ((float*)(ws + OFF_CSC))[cc * 512 + ch] = __expf(Glast - Gref);
            }
            bf16_t* q = (bf16_t*)(ws + OFF_Q); bf16_t* k = (bf16_t*)(ws + OFF_K); bf16_t* kT = (bf16_t*)(ws + OFF_KT);
            float G = pre, kk[16];
#pragma unroll
            for (int i = 0; i < 16; ++i) {
                G += la[i];
                const size_t idx = (size_t)(t0 + seg * 16 + i) * 512 + ch;
                const float qv = bf2f(q[idx]) * __expf(G - Gref);
                kk[i] = bf2f(k[idx]) * __expf(Gref - G);
                q[idx] = f2bf(qv); k[idx] = f2bf(kk[i]);
            }
            u32x4 v0, v1;
            v0.x = pack2(kk[0], kk[1]); v0.y = pack2(kk[2], kk[3]); v0.z = pack2(kk[4], kk[5]); v0.w = pack2(kk[6], kk[7]);
            v1.x = pack2(kk[8], kk[9]); v1.y = pack2(kk[10], kk[11]); v1.z = pack2(kk[12], kk[13]); v1.w = pack2(kk[14], kk[15]);
            *(u32x4*)(kT + tidx(ch, t0 + seg * 16)) = v0; *(u32x4*)(kT + tidx(ch, t0 + seg * 16 + 8)) = v1;
        }
    }
}

DI void phase_states(const Params& p) {
    const int T_ = opaque_tid();
    unsigned char* ws = p.ws;
    const int tid = VTID, lane = tid & 63, w = tid >> 6, lr = lane & 31, lh = lane >> 5;
    const bf16_t* xT = (const bf16_t*)(ws + OFF_XT); const bf16_t* BT = (const bf16_t*)(ws + OFF_BT);
    const float* wst = (const float*)(ws + OFF_WST);
    const bf16_t* vT = (const bf16_t*)(ws + OFF_VT); const bf16_t* kT = (const bf16_t*)(ws + OFF_KT);
    bf16_t* sst = (bf16_t*)p.out;
    bf16_t* gst = (bf16_t*)((unsigned char*)p.out + OUT_HALF);
    constexpr int U1 = 2048, U2 = 1024;
    for (int u = 2 * blockIdx.x + VB; u < U1 + U2; u += 2 * gridDim.x) {
        if (u < U1) {
            const int h = u & 15, cc = u >> 4, g = h >> 3, t0 = cc * 128;
            f32x16 acc[2] = {zero16(), zero16()};
#pragma unroll
            for (int ks = 0; ks < 8; ++ks) {
                const int tk = t0 + ks * 16 + 8 * lh;
                const bf16x8 b = ld_frag(BT + tidx(g * 128 + w * 32 + lr, tk));
                const f32x4 s0 = *(const f32x4*)(wst + (size_t)h * M_ + tk), s1 = *(const f32x4*)(wst + (size_t)h * M_ + tk + 4);
#pragma unroll
                for (int mi = 0; mi < 2; ++mi) {
                    const u32x4 xa = *(const u32x4*)(xT + tidx(h * 64 + mi * 32 + lr, tk));
                    u32x4 xs;
                    xs.x = pack2(bflo(xa.x) * s0[0], bfhi(xa.x) * s0[1]); xs.y = pack2(bflo(xa.y) * s0[2], bfhi(xa.y) * s0[3]);
                    xs.z = pack2(bflo(xa.z) * s1[0], bfhi(xa.z) * s1[1]); xs.w = pack2(bflo(xa.w) * s1[2], bfhi(xa.w) * s1[3]);
                    acc[mi] = MFMA(b, as_bf16x8(xs), acc[mi]);
                }
            }
            bf16_t* dst = sst + (size_t)(cc * 16 + h) * 64 * 128;
#pragma unroll
            for (int mi = 0; mi < 2; ++mi)
#pragma unroll
                for (int gq = 0; gq < 4; ++gq) { u32x2 v; v.x = pack2(acc[mi][4 * gq], acc[mi][4 * gq + 1]); v.y = pack2(acc[mi][4 * gq + 2], acc[mi][4 * gq + 3]);
                    *(u32x2*)(dst + sidx2(mi * 32 + lr, w * 32 + 8 * gq + 4 * lh)) = v; }
        } else {
            const int uu = u - U1, vh = uu & 1, hd = (uu >> 1) & 3, cc = uu >> 3, t0 = cc * 128;
            f32x16 acc[4] = {zero16(), zero16(), zero16(), zero16()};
            const int vrow = hd * 256 + vh * 128 + w * 32;
#pragma unroll
            for (int ks = 0; ks < 8; ++ks) {
                const int tk = t0 + ks * 16 + 8 * lh;
                const bf16x8 a = ld_frag(vT + tidx(vrow + lr, tk));
#pragma unroll
                for (int ni = 0; ni < 4; ++ni) {
                    const bf16x8 b = ld_frag(kT + tidx(hd * 128 + ni * 32 + lr, tk));
                    acc[ni] = MFMA(b, a, acc[ni]);
                }
            }
            bf16_t* dst = gst + (size_t)(cc * 4 + hd) * 256 * 128;
#pragma unroll
            for (int ni = 0; ni < 4; ++ni)
#pragma unroll
                for (int gq = 0; gq < 4; ++gq) { u32x2 v; v.x = pack2(acc[ni][4 * gq], acc[ni][4 * gq + 1]); v.y = pack2(acc[ni][4 * gq + 2], acc[ni][4 * gq + 3]);
                    *(u32x2*)(dst + sidx2(vh * 128 + w * 32 + lr, ni * 32 + 8 * gq + 4 * lh)) = v; }
        }
    }
}

DI void phase_carry(const Params& p) {
    const int T_ = opaque_tid();
    unsigned char* ws = p.ws;
    unsigned* sst = (unsigned*)p.out;
    unsigned* gst = (unsigned*)((unsigned char*)p.out + OUT_HALF);
    const float* cdec = (const float*)(ws + OFF_CDEC);
    const float* gref = (const float*)(ws + OFF_GREF); const float* glast = (const float*)(ws + OFF_GLAST); const float* csc = (const float*)(ws + OFF_CSC);
    constexpr int NE = 131072;
    for (int e = blockIdx.x * NT + T_; e < 2 * NE; e += gridDim.x * NT) {
        if (e < NE) {
            const int m = e & 4095, h = (e >> 12) & 15, b = e >> 16;
            float a0 = 0.f, a1 = 0.f;
#pragma unroll 8
            for (int c = 0; c < 64; ++c) {
                const int cc = b * 64 + c;
                unsigned* ptr = sst + (size_t)(cc * 16 + h) * 4096 + m;
                const unsigned s = *ptr;
                *ptr = pack2(a0, a1);
                const float d = cdec[cc * 16 + h];
                a0 = d * a0 + bflo(s); a1 = d * a1 + bfhi(s);
            }
        } else {
            const int e2 = e - NE;
            const int m = e2 & 16383, hd = (e2 >> 14) & 3, b = e2 >> 16;
            const int off = 2 * m, dd = ((off >> 9) & 7) * 16 + ((off >> 8) & 1) * 8 + (off & 7);
            float a0 = 0.f, a1 = 0.f;
#pragma unroll 8
            for (int c = 0; c < 64; ++c) {
                const int cc = b * 64 + c;
                unsigned* ptr = gst + (size_t)(cc * 4 + hd) * 16384 + m;
                const unsigned s = *ptr;
                const int fi = cc * 512 + hd * 128 + dd;
                *ptr = pack2(a0 * gref[fi], a1 * gref[fi + 1]);
                a0 = glast[fi] * a0 + csc[fi] * bflo(s); a1 = glast[fi + 1] * a1 + csc[fi + 1] * bfhi(s);
            }
        }
    }
}

DI void phase_mixer_out(const Params& p, unsigned char* smem) {
    const int T_ = opaque_tid();
    unsigned char* ws = p.ws;
    float* lds = (float*)(smem + VB * VB_LDS);
    const bf16_t* xT = (const bf16_t*)(ws + OFF_XT); const bf16_t* btm = (const bf16_t*)(ws + OFF_BTM); const bf16_t* ctm = (const bf16_t*)(ws + OFF_CTM);
    const float* dtp = (const float*)(ws + OFF_DT); const float* dac = (const float*)(ws + OFF_DAC);
    float* ssq = (float*)(ws + OFF_SSQ);
    bf16_t* zb = (bf16_t*)(ws + OFF_Z); bf16_t* rb = (bf16_t*)(ws + OFF_R);
    const bf16_t* qtm = (const bf16_t*)(ws + OFF_Q); const bf16_t* ktm = (const bf16_t*)(ws + OFF_K); const bf16_t* vT = (const bf16_t*)(ws + OFF_VT);
    const bf16_t* sst = (const bf16_t*)p.out;
    const bf16_t* gst = (const bf16_t*)((const unsigned char*)p.out + OUT_HALF);
    constexpr int U1 = 512, U2 = 1024;
    for (int u = 2 * blockIdx.x + VB; u < U1 + U2; u += 2 * gridDim.x) {
        int tid = VTID;
        asm volatile("" : "+v"(tid));
        const int lane = tid & 63, w = __builtin_amdgcn_readfirstlane(tid >> 6), lr = lane & 31, lh = lane >> 5;
#ifndef NO_SSD
        if (u < U1) {
            const int hq = u & 1, g = (u >> 1) & 1, cc = u >> 2, t0 = cc * 128;
            __syncthreads();
            for (int i = tid; i < 1024; i += NTHREADS) {
                const int tok = i >> 3, hh = i & 7;
                lds[i] = dac[(size_t)(t0 + tok) * 16 + g * 8 + hh];
                lds[1024 + i] = dtp[(size_t)(t0 + tok) * 16 + g * 8 + hh];
            }
            __syncthreads();
            const bf16_t* cp = ctm + (size_t)(t0 + w * 32 + lr) * 256 + g * 128 + 8 * lh;
            bf16x8 cf[8];
#pragma unroll
            for (int ks = 0; ks < 8; ++ks) cf[ks] = ld_frag(cp + ks * 16);
            float ssq_acc[16];
#pragma unroll
            for (int r = 0; r < 16; ++r) ssq_acc[r] = 0.f;
#pragma unroll 1
            for (int hh = hq * 4; hh < hq * 4 + 4; ++hh) {
                const int h = g * 8 + hh;
                f32x16 acc[2] = {zero16(), zero16()};
                const bf16_t* hent = sst + (size_t)(cc * 16 + h) * 64 * 128;
#pragma unroll
                for (int ks = 0; ks < 8; ++ks) {
#pragma unroll
                    for (int ni = 0; ni < 2; ++ni)
                        acc[ni] = MFMA(cf[ks], ld_frag(hent + sidx2(ni * 32 + lr, ks * 16 + 8 * lh)), acc[ni]);
                }
#pragma unroll
                for (int r = 0; r < 16; ++r) {
                    const float e = __expf(lds[(w * 32 + crow(r, lh)) * 8 + hh]);
                    acc[0][r] *= e; acc[1][r] *= e;
                }
                const float dAi = lds[(w * 32 + lr) * 8 + hh];
#pragma unroll 1
                for (int jt = 0; jt <= w; ++jt) {
                    const bf16_t* bp = btm + (size_t)(t0 + jt * 32 + lr) * 256 + g * 128 + 8 * lh;
                    bf16x8 bfr[8];
#pragma unroll
                    for (int ks = 0; ks < 8; ++ks) bfr[ks] = ld_frag(bp + ks * 16);
                    bf16x8 xf[2][2];
#pragma unroll
                    for (int s = 0; s < 2; ++s)
#pragma unroll
                        for (int ni = 0; ni < 2; ++ni) {
                            const int xch = h * 64 + ni * 32 + lr, xt = t0 + jt * 32 + 16 * s;
                            xf[s][ni] = ld_frag2(xT + tidx(xch, xt) + 4 * lh, xT + tidx(xch, xt + 8) + 4 * lh);
                        }
                    f32x16 ST = zero16();
#pragma unroll
                    for (int ks = 0; ks < 8; ++ks) ST = MFMA(bfr[ks], cf[ks], ST);
#pragma unroll
                    for (int r = 0; r < 16; ++r) {
                        const int jl = crow(r, lh), j = jt * 32 + jl;
                        const float v = ST[r] * __expf(dAi - lds[j * 8 + hh]) * lds[1024 + j * 8 + hh];
                        ST[r] = (jt < w || jl <= lr) ? v : 0.f;
                    }
#pragma unroll
                    for (int s = 0; s < 2; ++s) {
                        const bf16x8 af = pack_step(ST, s);
#pragma unroll
                        for (int ni = 0; ni < 2; ++ni) acc[ni] = MFMA(af, xf[s][ni], acc[ni]);
                    }
                }
                __builtin_amdgcn_sched_barrier(0);
                const float Dh = p.in[6][h];
#pragma unroll
                for (int ni = 0; ni < 2; ++ni) {
                    __builtin_amdgcn_sched_barrier(0);
                    const int ch = h * 64 + ni * 32 + lr;
                    const float gn = p.in[7][ch];
#pragma unroll
                    for (int rg = 0; rg < 4; ++rg) {
                        const int tb = t0 + w * 32 + 8 * rg + 4 * lh;
                        const u32x2 xv = *(const u32x2*)(xT + tidx(ch, tb));
                        const float xs[4] = {bflo(xv.x), bfhi(xv.x), bflo(xv.y), bfhi(xv.y)};
#pragma unroll
                        for (int e = 0; e < 4; ++e) {
                            const int r = 4 * rg + e;
                            const size_t zi = (size_t)(tb + e) * 1024 + ch;
                            float y = acc[ni][r] + Dh * xs[e];
                            y *= siluf_(bf2f(zb[zi]));
                            ssq_acc[r] += y * y;
                            zb[zi] = f2bf(y * gn);
                        }
                    }
                }
            }
#pragma unroll
            for (int r = 0; r < 16; ++r) {
                const float v = half_reduce(ssq_acc[r]);
                if (lr == 0) atomicAdd(ssq + t0 + w * 32 + crow(r, lh), v);
            }
        }
#endif
#ifndef NO_GLA
        if (u >= U1) {
            const int uu = u - U1, half = (uu ^ (uu >> 9)) & 1, hd = (uu >> 1) & 3, cc = uu >> 3, t0 = cc * 128;
            const int rt = 2 * half + (w >> 1), vh = w & 1;
            bf16x8 qf[8];
#pragma unroll
            for (int ks = 0; ks < 8; ++ks) qf[ks] = ld_frag(qtm + (size_t)(t0 + rt * 32 + lr) * 512 + hd * 128 + ks * 16 + 8 * lh);
            f32x16 o[4] = {zero16(), zero16(), zero16(), zero16()};
            const bf16_t* sent = gst + (size_t)(cc * 4 + hd) * 256 * 128;
#pragma unroll
            for (int ks = 0; ks < 8; ++ks)
#pragma unroll
                for (int ni = 0; ni < 4; ++ni)
                    o[ni] = MFMA(qf[ks], ld_frag(sent + sidx2(vh * 128 + ni * 32 + lr, ks * 16 + 8 * lh)), o[ni]);
#pragma unroll 1
            for (int jt = 0; jt <= rt; ++jt) {
                f32x16 ST = zero16();
                const bf16_t* kp = ktm + (size_t)(t0 + jt * 32 + lr) * 512 + hd * 128 + 8 * lh;
#pragma unroll
                for (int ks = 0; ks < 8; ++ks) ST = MFMA(ld_frag(kp + ks * 16), qf[ks], ST);
                if (jt == rt) {
#pragma unroll
                    for (int r = 0; r < 16; ++r) ST[r] = (crow(r, lh) <= lr) ? ST[r] : 0.f;
                }
#pragma unroll
                for (int s = 0; s < 2; ++s) {
                    const bf16x8 af = pack_step(ST, s);
#pragma unroll
                    for (int ni = 0; ni < 4; ++ni) {
                        const int vch = hd * 256 + vh * 128 + ni * 32 + lr, vt = t0 + jt * 32 + 16 * s;
                        o[ni] = MFMA(af, ld_frag2(vT + tidx(vch, vt) + 4 * lh, vT + tidx(vch, vt + 8) + 4 * lh), o[ni]);
                    }
                }
            }
            float ss[16];
#pragma unroll
            for (int r = 0; r < 16; ++r) {
                float v = 0.f;
#pragma unroll
                for (int ni = 0; ni < 4; ++ni) v += o[ni][r] * o[ni][r];
                ss[r] = half_reduce(v);
            }
            __syncthreads();
            if (lr == 0) {
#pragma unroll
                for (int r = 0; r < 16; ++r) lds[w * 32 + lh * 16 + r] = ss[r];
            }
            __syncthreads();
#pragma unroll
            for (int r = 0; r < 16; ++r) ss[r] = rsqrtf((ss[r] + lds[(w ^ 1) * 32 + lh * 16 + r]) * (1.f / 256.f) + LN_EPS);
            const int par = lr & 1;
#pragma unroll
            for (int ni = 0; ni < 4; ++ni) {
                const int ch = hd * 256 + vh * 128 + ni * 32 + lr;
                const float gn = p.in[10][ch];
#pragma unroll
                for (int k = 0; k < 8; ++k) {
                    const float pre0 = o[ni][2 * k] * ss[2 * k] * gn, pre1 = o[ni][2 * k + 1] * ss[2 * k + 1] * gn;
                    const float recv = __shfl_xor(par ? pre0 : pre1, 1);
                    const float lo = par ? recv : pre0, hi = par ? pre1 : recv;
                    unsigned* gp = (unsigned*)(rb + (size_t)(t0 + rt * 32 + crow(2 * k, lh) + par) * 1024 + (ch & ~1));
                    const unsigned u = *gp;
                    *gp = pack2(lo * siluf_(bflo(u)), hi * siluf_(bfhi(u)));
                }
            }
        }
#endif
    }
}

DI void phase_ln(const float* src, float* dst, bf16_t* dstb, const float* g, const float* b) {
    const int T_ = opaque_tid();
    const int lane = T_ & 63, w = T_ >> 6;
    for (int r8 = blockIdx.x; r8 < M_ / 8; r8 += gridDim.x) {
        const int row = r8 * 8 + w;
        const float* s = src + (size_t)row * 1024;
        f32x4 v[4];
        float sum = 0.f;
#pragma unroll
        for (int i = 0; i < 4; ++i) { v[i] = *(const f32x4*)(s + i * 256 + lane * 4); sum += v[i][0] + v[i][1] + v[i][2] + v[i][3]; }
        sum = half_reduce(sum); sum += __shfl_xor(sum, 32);
        const float mu = sum * (1.f / 1024.f);
        float sq = 0.f;
#pragma unroll
        for (int i = 0; i < 4; ++i)
#pragma unroll
            for (int e = 0; e < 4; ++e) { const float d = v[i][e] - mu; sq += d * d; }
        sq = half_reduce(sq); sq += __shfl_xor(sq, 32);
        const float rs = rsqrtf(sq * (1.f / 1024.f) + LN_EPS);
#pragma unroll
        for (int i = 0; i < 4; ++i) {
            const int c = i * 256 + lane * 4;
            const f32x4 gv = *(const f32x4*)(g + c), bv = *(const f32x4*)(b + c);
            f32x4 o;
#pragma unroll
            for (int e = 0; e < 4; ++e) o[e] = (v[i][e] - mu) * rs * gv[e] + bv[e];
            *(f32x4*)(dst + (size_t)row * 1024 + c) = o;
            if (dstb) { u32x2 pk; pk.x = pack2(o[0], o[1]); pk.y = pack2(o[2], o[3]); *(u32x2*)(dstb + (size_t)row * 1024 + c) = pk; }
        }
    }
}

struct S5Lane { float abr[2], abi[2]; bf16x8 bfrag[4]; };
DI void s5_setup(const unsigned char* ws, int g, int lr, int lh, S5Lane& L) {
    const float* ab = (const float*)(ws + OFF_S5AB);
#pragma unroll
    for (int q = 0; q < 2; ++q) { L.abr[q] = ab[(g * 64 + 32 * q + lr) * 2]; L.abi[q] = ab[(g * 64 + 32 * q + lr) * 2 + 1]; }
#pragma unroll
    for (int nt = 0; nt < 4; ++nt) L.bfrag[nt] = ld_frag((const bf16_t*)(ws + OFF_S5BB) + ((((size_t)g * 4 + nt) * 2 + lh) * 32 + lr) * 8);
}
DI int s5_row_token(int pr, int tile, int r) { return (2 * pr + ((r >> 2) & 1)) * S5CH + tile * 16 + 4 * (r >> 3) + (r & 3); }

DI void phase_s5_local(const Params& p) {
    const int T_ = opaque_tid();
    unsigned char* ws = p.ws;
    const int tid = T_, lane = tid & 63, w = tid >> 6, lr = lane & 31, lh = lane >> 5;
    const bf16_t* xb = (const bf16_t*)p.out;
    float* sloc = (float*)(ws + OFF_SLOC);
    for (int bu = blockIdx.x; bu < (S5NCH / 2) * 64 / 8; bu += gridDim.x) {
        const int wu = bu * 8 + w, g = wu & 63, pr = wu >> 6;
        S5Lane L; s5_setup(ws, g, lr, lh, L);
        float cr[2] = {0.f, 0.f}, ci[2] = {0.f, 0.f};
#pragma unroll 2
        for (int tile = 0; tile < S5CH / 16; ++tile) {
            const bf16x8 a = ld_frag(xb + (size_t)s5_row_token(pr, tile, lr) * 1024 + g * 16 + 8 * lh);
            f32x16 buv[4];
#pragma unroll
            for (int nt = 0; nt < 4; ++nt) buv[nt] = MFMA(a, L.bfrag[nt], zero16());
#pragma unroll
            for (int q = 0; q < 2; ++q) {
                const float ar = L.abr[q], ai = L.abi[q];
                float sr = cr[q], si = ci[q];
#pragma unroll
                for (int i = 0; i < 16; ++i) { const float nr = ar * sr - ai * si + buv[2 * q][i], ni = ar * si + ai * sr + buv[2 * q + 1][i]; sr = nr; si = ni; }
                cr[q] = sr; ci[q] = si;
            }
        }
        const int ck = 2 * pr + lh;
#pragma unroll
        for (int q = 0; q < 2; ++q) { float* d = sloc + ((size_t)(ck * 64 + g) * 64 + 32 * q + lr) * 2; d[0] = cr[q]; d[1] = ci[q]; }
    }
}
DI void phase_s5_carry(const Params& p) {
    const int T_ = opaque_tid();
    unsigned char* ws = p.ws;
    const float* sloc = (const float*)(ws + OFF_SLOC); float* sent = (float*)(ws + OFF_SENT);
    for (int e = blockIdx.x * NT + T_; e < 8192; e += gridDim.x * NT) {
        const int pp = e & 63, g = (e >> 6) & 63, b = e >> 12;
        const float step = __expf(p.in[21][g]);
        const float ar = p.in[19][g * 64 + pp], ai = p.in[20][g * 64 + pp];
        const float mag = expf(ar * step);
        float sn, cs; sincosf(ai * step, &sn, &cs);
        float tr = mag * cs, ti = mag * sn;
        for (int i = 0; i < 7; ++i) { const float nr = tr * tr - ti * ti, ni = 2.f * tr * ti; tr = nr; ti = ni; }
        static_assert(S5CH == 128, "squaring count");
        float sr = 0.f, si = 0.f;
        typedef float f32x2_ __attribute__((ext_vector_type(2)));
        const f32x2_* __restrict__ sl2 = (const f32x2_*)sloc;
        f32x2_* __restrict__ se2 = (f32x2_*)sent;
#pragma unroll 1
        for (int kb = 0; kb < S5CPB; kb += 16) {
            f32x2_ lv[16];
#pragma unroll
            for (int i = 0; i < 16; ++i) lv[i] = sl2[(size_t)((b * S5CPB + kb + i) * 64 + g) * 64 + pp];
#pragma unroll
            for (int i = 0; i < 16; ++i) {
                f32x2_ o; o.x = sr; o.y = si;
                se2[(size_t)((b * S5CPB + kb + i) * 64 + g) * 64 + pp] = o;
                const float nr = tr * sr - ti * si + lv[i].x, ni = tr * si + ti * sr + lv[i].y;
                sr = nr; si = ni;
            }
        }
    }
}
DI void phase_s5_out(const Params& p, unsigned char* smem) {
    const int T_ = opaque_tid();
    unsigned char* ws = p.ws;
    const int tid = T_, lane = tid & 63, w = tid >> 6, lr = lane & 31, lh = lane >> 5;
    const bf16_t* xb = (const bf16_t*)p.out;
    bf16_t* yb = (bf16_t*)((unsigned char*)p.out + OUT_HALF);
    const float* xf = (const float*)(ws + OFF_U);
    const float* sent = (const float*)(ws + OFF_SENT);
    constexpr int SROW = 136;
    bf16_t* sl = (bf16_t*)smem + w * 32 * SROW;
    unsigned* sl32 = (unsigned*)sl;
    for (int bu = blockIdx.x; bu < (S5NCH / 2) * 64 / 8; bu += gridDim.x) {
        const int wu = bu * 8 + w, g = wu & 63, pr = wu >> 6;
        S5Lane L; s5_setup(ws, g, lr, lh, L);
        bf16x8 cfr[4];
#pragma unroll
        for (int ks = 0; ks < 4; ++ks) cfr[ks] = ld_frag((const bf16_t*)(ws + OFF_S5CM) + (((size_t)g * 4 + ks) * 64 + lane) * 8);
        const int ck = 2 * pr + lh;
        float cr[2], ci[2];
#pragma unroll
        for (int q = 0; q < 2; ++q) { const float* s0 = sent + ((size_t)(ck * 64 + g) * 64 + 32 * q + lr) * 2; cr[q] = s0[0]; ci[q] = s0[1]; }
        const int ch = g * 16 + (lane & 15);
        const float Dv = p.in[26][ch];
        bf16x8 a_nxt = ld_frag(xb + (size_t)s5_row_token(pr, 0, lr) * 1024 + g * 16 + 8 * lh);
#pragma unroll 1
        for (int tile = 0; tile < S5CH / 16; ++tile) {
            const bf16x8 a = a_nxt;
            if (tile + 1 < S5CH / 16) a_nxt = ld_frag(xb + (size_t)s5_row_token(pr, tile + 1, lr) * 1024 + g * 16 + 8 * lh);
            f32x16 buv[4];
#pragma unroll
            for (int nt = 0; nt < 4; ++nt) buv[nt] = MFMA(a, L.bfrag[nt], zero16());
            asm volatile("s_waitcnt lgkmcnt(0)" ::: "memory");
#pragma unroll
            for (int q = 0; q < 2; ++q) {
                const float ar = L.abr[q], ai = L.abi[q];
                float sr = cr[q], si = ci[q];
#pragma unroll
                for (int i = 0; i < 16; ++i) {
                    const float nr = ar * sr - ai * si + buv[2 * q][i], ni = ar * si + ai * sr + buv[2 * q + 1][i]; sr = nr; si = ni;
                    sl32[(16 * lh + i) * (SROW / 2) + 32 * q + lr] = pack2(sr, si);
                }
                cr[q] = sr; ci[q] = si;
            }
            asm volatile("s_waitcnt lgkmcnt(0)" ::: "memory");
#pragma unroll
            for (int t16 = 0; t16 < 2; ++t16) {
                f32x4 y = {0.f, 0.f, 0.f, 0.f};
#pragma unroll
                for (int ks = 0; ks < 4; ++ks)
                    y = __builtin_amdgcn_mfma_f32_16x16x32_bf16(ld_frag(sl + (t16 * 16 + (lane & 15)) * SROW + ks * 32 + 8 * (lane >> 4)), cfr[ks], y, 0, 0, 0);
#pragma unroll
                for (int r = 0; r < 4; ++r) {
                    const size_t idx = (size_t)((2 * pr + t16) * S5CH + tile * 16 + (lane >> 4) * 4 + r) * 1024 + ch;
                    yb[idx] = f2bf(gelu_tanh(y[r] + Dv * xf[idx]));
                }
            }
        }
    }
}

#define XB_TMO      128
#define XB_XCNT(j)  (256  + 64 * (j))
#define XB_XSUB(j)  (1280 + 64 * (j))
#define XB_XGEN(j)  (2304 + 64 * (j))
#define XB_TOP      3328
#define XB_TOPGEN   3392
#define XCD_BAR_WORDS 3456
#define XB_SPIN_CAP (1u << 18)
#define LAS __attribute__((address_space(3)))

__device__ __forceinline__ unsigned xb_ld(unsigned* p)              { return __hip_atomic_load(p, __ATOMIC_RELAXED, __HIP_MEMORY_SCOPE_AGENT); }
__device__ __forceinline__ unsigned xb_add(unsigned* p, unsigned v) { return __hip_atomic_fetch_add(p, v, __ATOMIC_RELAXED, __HIP_MEMORY_SCOPE_AGENT); }
__device__ __forceinline__ unsigned xb_xcc_id() { return (unsigned)__builtin_amdgcn_s_getreg((3 << 11) | 20) & 0xFu; }
#define XB_SPIN(cond, bar) do { unsigned _sp = 0; while (cond) { __builtin_amdgcn_s_sleep(1); \
    if ((++_sp & 255u) == 0u) { if (xb_ld(&(bar)[XB_TMO])) break; if (_sp > XB_SPIN_CAP) { atomicAdd(&(bar)[XB_TMO], 1u); break; } } } } while (0)

struct XcdBarrier {
    unsigned* bar; unsigned x;
    volatile LAS unsigned* st;
};

__device__ __forceinline__ XcdBarrier xcd_barrier_post(unsigned* bar, volatile LAS unsigned* st) {
    XcdBarrier b; b.bar = bar; b.x = xb_xcc_id(); b.st = st;
    if (threadIdx.x == 0) (void)xb_add(&bar[XB_XCNT(b.x)], 1u);
    return b;
}
__device__ __forceinline__ void xcd_barrier_complete(unsigned* bar, unsigned x, unsigned& nloc, unsigned& nx) {
    const unsigned G = gridDim.x * gridDim.y * gridDim.z;
    unsigned sum, cnt, mine, sp = 0u;
    for (;;) {
        sum = 0u; cnt = 0u; mine = 0u;
#pragma unroll
        for (unsigned j = 0; j < 16; ++j) { const unsigned c = xb_ld(&bar[XB_XCNT(j)]); sum += c; cnt += (c > 0u) ? 1u : 0u; mine = (j == x) ? c : mine; }
        if (sum == G) break;
        __builtin_amdgcn_s_sleep(1);
        if ((++sp & 255u) == 0u) { if (xb_ld(&bar[XB_TMO])) break; if (sp > XB_SPIN_CAP) { atomicAdd(&bar[XB_TMO], 1u); break; } }
    }
    nloc = mine > 0u ? mine : 1u; nx = cnt > 0u ? cnt : 1u;
}

__device__ __forceinline__ void xcd_barrier(const XcdBarrier& b) {
    asm volatile("s_waitcnt vmcnt(0)" ::: "memory");
    __syncthreads();
    if (threadIdx.x == 0) {
        unsigned* bar = b.bar;
        unsigned bx_ = b.x;
        asm volatile("" : "+s"(bx_));
        __builtin_amdgcn_s_waitcnt(0);
        unsigned nloc = b.st[0], nx = b.st[1];
        if (nloc == 0u) { xcd_barrier_complete(bar, bx_, nloc, nx); b.st[0] = nloc; b.st[1] = nx; }
        const unsigned old = xb_add(&bar[XB_XSUB(bx_)], 1u);
        const unsigned gen = old / nloc;
        if (old + 1u == (gen + 1u) * nloc) {
            __builtin_amdgcn_fence(__ATOMIC_RELEASE, "agent");
            asm volatile("s_waitcnt vmcnt(0)" ::: "memory");
            const unsigned og = xb_add(&bar[XB_TOP], 1u);
            const unsigned tg = og / nx;
            if (og + 1u == (tg + 1u) * nx) xb_add(&bar[XB_TOPGEN], 1u);
            else XB_SPIN(xb_ld(&bar[XB_TOPGEN]) == tg, bar);
            __builtin_amdgcn_fence(__ATOMIC_ACQUIRE, "agent");
            xb_add(&bar[XB_XGEN(bx_)], 1u);
            asm volatile("s_waitcnt vmcnt(0)" ::: "memory");
        } else {
            XB_SPIN(xb_ld(&bar[XB_XGEN(bx_)]) == gen, bar);
            __builtin_amdgcn_fence(__ATOMIC_ACQUIRE, "agent");
            asm volatile("s_waitcnt vmcnt(0)" ::: "memory");
        }
    }
    __syncthreads();
}


constexpr int NPHASE = 19;
#ifdef ONLY_PHASE
#define PEN(n) ((n) == ONLY_PHASE)
#else
#define PEN(n) true
#endif
__global__ void __launch_bounds__(NT) mega(Params p) {
    __builtin_assume(__builtin_amdgcn_workitem_id_y() == 0);
    __builtin_assume(__builtin_amdgcn_workitem_id_z() == 0);
    extern __shared__ __attribute__((aligned(16))) unsigned char smem[];
    cg::grid_group grid = cg::this_grid();
    unsigned char* ws = p.ws;
    float* U = (float*)(ws + OFF_U);
    bf16_t* xb = (bf16_t*)p.out;
    bf16_t* yb = (bf16_t*)((unsigned char*)p.out + OUT_HALF);
    bf16_t* hmid = (bf16_t*)(ws + OFF_HMID);
    bf16_t* shm = (bf16_t*)smem;
    volatile LAS unsigned* xst = (volatile LAS unsigned*)(smem + g8::SHM_B);
    if (threadIdx.x < 2) xst[threadIdx.x] = 0u;
    __syncthreads();
    const XcdBarrier gbar = xcd_barrier_post((unsigned*)(ws + OFF_BAR), xst);
#ifndef DUP
#define DUP 0
#endif
#define PHASE_BEGIN(n) for (int rep_ = 0; rep_ < (((DUP) >> (n)) & 1) + 1; ++rep_) { if (PEN(n)) {
#define PHASE_END }  xcd_barrier(gbar); }
    if (PEN(0)) phase_prep0(p, smem);
    if (p.ph_hi) grid.sync();
    xcd_barrier(gbar);
    PHASE_BEGIN(1)
        EpiInProj e{(bf16_t*)(ws + OFF_Z), (bf16_t*)(ws + OFF_XT), (bf16_t*)(ws + OFF_BTM), (bf16_t*)(ws + OFF_CTM), (bf16_t*)(ws + OFF_Q), (bf16_t*)(ws + OFF_K),
                    (bf16_t*)(ws + OFF_VT), (bf16_t*)(ws + OFF_R), (bf16_t*)(ws + OFF_XHALO), (bf16_t*)(ws + OFF_BCHALO), (float*)(ws + OFF_DT), (float*)(ws + OFF_GA), p.in[4]};
        g8::phase(xb, 1024, (const bf16_t*)(ws + OFF_WT_IN), 1024, 1024, M_, NIN, shm, e);
    PHASE_END
    PHASE_BEGIN(2) phase_conv_gates(p, smem); PHASE_END
    PHASE_BEGIN(3) phase_states(p); PHASE_END
    PHASE_BEGIN(4) phase_carry(p); PHASE_END
    PHASE_BEGIN(5) phase_mixer_out(p, smem); PHASE_END
    PHASE_BEGIN(6)
        EpiResidual<0> e0{U, p.in[0], nullptr};
        g8::phase((const bf16_t*)(ws + OFF_R), 1024, (const bf16_t*)(ws + OFF_WT_OUT) + 1024, 2048, 1024, M_, 1024, shm, e0);
        EpiResidual<1> e1{U, nullptr, (const float*)(ws + OFF_SSQ)};
        g8::phase((const bf16_t*)(ws + OFF_Z), 1024, (const bf16_t*)(ws + OFF_WT_OUT), 2048, 1024, M_, 1024, shm, e1);
    PHASE_END
    PHASE_BEGIN(7) phase_ln(U, U, xb, p.in[12], p.in[13]); PHASE_END
    PHASE_BEGIN(8) EpiSwiGLU e{hmid}; g8::phase(xb, 1024, (const bf16_t*)(ws + OFF_WT_GU0), 1024, 1024, M_, 5632, shm, e);
        __syncthreads();
        prep_w1(p, smem, (int)gridDim.x == 256 ? 128 : 0);
    PHASE_END
    PHASE_BEGIN(9) EpiResidual<0> e{U, U, nullptr}; g8::phase(hmid, FFH, (const bf16_t*)(ws + OFF_WT_DN0), FFH, FFH, M_, 1024, shm, e); PHASE_END
    PHASE_BEGIN(10) phase_ln(U, U, xb, p.in[17], p.in[18]); PHASE_END
    PHASE_BEGIN(11) phase_s5_local(p); PHASE_END
    PHASE_BEGIN(12) phase_s5_carry(p); PHASE_END
    PHASE_BEGIN(13) phase_s5_out(p, smem); PHASE_END
    PHASE_BEGIN(14) EpiGLU e{U, p.in[28], p.in[30]}; g8::phase(yb, 1024, (const bf16_t*)(ws + OFF_WT_GLU), 1024, 1024, M_, 2048, shm, e); PHASE_END
    PHASE_BEGIN(15) phase_ln(U, U, xb, p.in[31], p.in[32]); PHASE_END
    PHASE_BEGIN(16) EpiSwiGLU e{hmid}; g8::phase(xb, 1024, (const bf16_t*)(ws + OFF_WT_GU1), 1024, 1024, M_, 5632, shm, e); PHASE_END
    PHASE_BEGIN(17) EpiResidual<0> e{U, U, nullptr}; g8::phase(hmid, FFH, (const bf16_t*)(ws + OFF_WT_DN1), FFH, FFH, M_, 1024, shm, e); PHASE_END
    if (PEN(18)) phase_ln(U, p.out, nullptr, p.in[36], p.in[37]);
}

extern "C" void kernel_launch(void* const* d_in, const int* in_sizes, int n_in, void* d_out, int out_size, void* d_ws, size_t ws_size, hipStream_t stream) {
    static int grid_blocks = 0;
    constexpr size_t kDynLds = g8::SHM_B + 16;
    if (grid_blocks == 0) {
        if (n_in != 38 || out_size != M_ * D_ || ws_size < WS_TOTAL) { fprintf(stderr, "kernel_launch: unexpected shapes (n_in %d out %d ws %zu need %zu)\n", n_in, out_size, ws_size, (size_t)WS_TOTAL); grid_blocks = -1; return; }
        int dev = 0, cus = 0, per_cu = 0;
        (void)hipGetDevice(&dev);
        (void)hipDeviceGetAttribute(&cus, hipDeviceAttributeMultiprocessorCount, dev);
        if (hipFuncSetAttribute((const void*)mega, hipFuncAttributeMaxDynamicSharedMemorySize, (int)kDynLds) != hipSuccess) { fprintf(stderr, "hipFuncSetAttribute failed\n"); (void)hipGetLastError(); }
        if (hipOccupancyMaxActiveBlocksPerMultiprocessor(&per_cu, (const void*)mega, NT, kDynLds) != hipSuccess || per_cu < 1) { fprintf(stderr, "occupancy query failed (%d)\n", per_cu); (void)hipGetLastError(); per_cu = 1; }
        grid_blocks = cus;
        (void)per_cu;
    }
    if (grid_blocks < 0) return;
    if (hipMemsetAsync((unsigned char*)d_ws + OFF_BAR, 0, 3456 * 4, stream) != hipSuccess) { fprintf(stderr, "barrier memset failed\n"); return; }
    Params p{};
    for (int i = 0; i < 38; ++i) p.in[i] = (const float*)d_in[i];
    p.out = (float*)d_out; p.ws = (unsigned char*)d_ws; p.ph_lo = 0; p.ph_hi = 0;
    void* args[] = {&p};
    hipError_t e = hipLaunchCooperativeKernel((const void*)mega, dim3(grid_blocks), dim3(NT), args, kDynLds, stream);
    if (e != hipSuccess) fprintf(stderr, "cooperative launch failed: %s (grid %d)\n", hipGetErrorString(e), grid_blocks);
}
```

```cpp
#include <hip/hip_runtime.h>
#include <hip/hip_cooperative_groups.h>
#include <cstdio>
#include <cstdint>
namespace cg = cooperative_groups;

#define DI __device__ __forceinline__
typedef unsigned short bf16_t;
typedef short bf16x8 __attribute__((ext_vector_type(8)));
typedef float f32x16 __attribute__((ext_vector_type(16)));
typedef float f32x4 __attribute__((ext_vector_type(4)));
typedef unsigned u32x4 __attribute__((ext_vector_type(4)));
typedef unsigned u32x2 __attribute__((ext_vector_type(2)));

#define MFMA(a, b, c) __builtin_amdgcn_mfma_f32_32x32x16_bf16((a), (b), (c), 0, 0, 0)

constexpr int M_ = 16384, D_ = 1024, L_ = 8192;
constexpr int NTHREADS = 256;
constexpr int NT = 512;
constexpr int VB_LDS = 36864;
#define VB (T_ >> 8)
#define VTID (T_ & 255)
__device__ __forceinline__ int opaque_tid() { int t = threadIdx.x; asm volatile("" : "+v"(t)); return t; }
constexpr float DN_ALPHA = 1.4142135623730951f;
constexpr float LN_EPS = 1e-5f;
constexpr int FFH = 2816;
constexpr int NIN = 5888;

constexpr size_t SZ_WT_IN = (size_t)NIN * 1024 * 2;
constexpr size_t SZ_WT_OUT = (size_t)1024 * 2048 * 2;
constexpr size_t SZ_WT_GU = (size_t)5632 * 1024 * 2;
constexpr size_t SZ_WT_DN = (size_t)1024 * 2816 * 2;
constexpr size_t SZ_WT_GLU = (size_t)2048 * 1024 * 2;
constexpr size_t OFF_WT_IN = 0;
constexpr size_t OFF_WT_OUT = OFF_WT_IN + SZ_WT_IN;
constexpr size_t OFF_WT_GU0 = OFF_WT_OUT + SZ_WT_OUT;
constexpr size_t OFF_WT_DN0 = OFF_WT_GU0 + SZ_WT_GU;
constexpr size_t OFF_U = OFF_WT_DN0 + SZ_WT_DN;
constexpr size_t SZ_U = (size_t)M_ * 1024 * 4;
constexpr size_t OFF_XT = OFF_U;
constexpr size_t OFF_BTM = OFF_XT + (size_t)1024 * M_ * 2;
constexpr size_t OFF_CTM = OFF_BTM + (size_t)M_ * 256 * 2;
constexpr size_t OFF_BT = OFF_CTM + (size_t)M_ * 256 * 2;
constexpr size_t OFF_H = OFF_U + SZ_U;
constexpr size_t SZ_H = (size_t)M_ * 3584 * 2;
constexpr size_t OFF_Z = OFF_H;
constexpr size_t OFF_R = OFF_Z + (size_t)M_ * 1024 * 2;
constexpr size_t OFF_Q = OFF_R + (size_t)M_ * 1024 * 2;
constexpr size_t OFF_K = OFF_Q + (size_t)M_ * 512 * 2;
constexpr size_t OFF_KT = OFF_K + (size_t)M_ * 512 * 2;
constexpr size_t OFF_HMID = OFF_H;
constexpr size_t OFF_W1 = OFF_H + (size_t)M_ * 2816 * 2;
constexpr size_t OFF_WT_GLU = OFF_W1;
constexpr size_t OFF_WT_GU1 = OFF_WT_GLU + SZ_WT_GLU;
constexpr size_t OFF_WT_DN1 = OFF_WT_GU1 + SZ_WT_GU;
static_assert(OFF_WT_DN1 + SZ_WT_DN <= OFF_H + SZ_H, "W1 must fit in H tail");
constexpr size_t OFF_SLOC = OFF_H;
constexpr int S5CH = 128, S5NCH = M_ / S5CH, S5CPB = L_ / S5CH, S5TILES = S5CH / 32;
constexpr size_t OFF_SENT = OFF_SLOC + (size_t)256 * 64 * 64 * 2 * 4;
constexpr size_t OFF_VT = OFF_H + SZ_H;
constexpr size_t OFF_SM = OFF_VT + (size_t)1024 * M_ * 2;
constexpr size_t OFF_DT = OFF_SM;
constexpr size_t OFF_GA = OFF_DT + (size_t)M_ * 16 * 4;
constexpr size_t OFF_DAC = OFF_GA + (size_t)M_ * 16 * 4;
constexpr size_t OFF_WST = OFF_DAC + (size_t)M_ * 16 * 4;
constexpr size_t OFF_SSQ = OFF_WST + (size_t)M_ * 16 * 4;
constexpr size_t OFF_XHALO = OFF_SSQ + (size_t)M_ * 4;
constexpr size_t OFF_BCHALO = OFF_XHALO + (size_t)128 * 1024 * 4 * 2;
constexpr size_t OFF_CDEC = OFF_BCHALO + (size_t)128 * 4 * 512 * 2;
constexpr size_t OFF_GREF = OFF_CDEC + (size_t)128 * 16 * 4;
constexpr size_t OFF_GLAST = OFF_GREF + (size_t)128 * 512 * 4;
constexpr size_t OFF_CSC = OFF_GLAST + (size_t)128 * 512 * 4;
constexpr size_t WS_END = OFF_CSC + (size_t)128 * 512 * 4;
constexpr size_t OFF_S5AB = (WS_END + 255) & ~(size_t)255;
constexpr size_t OFF_S5BB = OFF_S5AB + (size_t)64 * 64 * 2 * 4;
constexpr size_t OFF_S5CM = OFF_S5BB + (size_t)64 * 4 * 2 * 32 * 8 * 2;
constexpr size_t OFF_BAR = OFF_S5CM + (size_t)64 * 8 * 2 * 32 * 8 * 2;
constexpr size_t WS_TOTAL = OFF_BAR + 3456 * 4;
static_assert(WS_TOTAL <= (size_t)256 * 1024 * 1024, "workspace overflow");
constexpr size_t OUT_HALF = (size_t)M_ * 1024 * 2;

struct Params {
    const float* in[38];
    float* out;
    unsigned char* ws;
    int ph_lo, ph_hi;
};

typedef __bf16 hwbf2 __attribute__((ext_vector_type(2)));
typedef float f32x2h __attribute__((ext_vector_type(2)));
DI bf16_t f2bf(float x) { return __builtin_bit_cast(bf16_t, (__bf16)x); }
DI float bf2f(bf16_t b) { return __uint_as_float(((unsigned)b) << 16); }
DI unsigned pack2(float a, float b) { f32x2h v; v.x = a; v.y = b; return __builtin_bit_cast(unsigned, __builtin_convertvector(v, hwbf2)); }
DI float bflo(unsigned u) { return __uint_as_float(u << 16); }
DI float bfhi(unsigned u) { return __uint_as_float(u & 0xffff0000u); }
DI int crow(int reg, int h) { return (reg & 3) + 8 * (reg >> 2) + 4 * h; }
DI size_t tidx(int ch, int tok) { return ((((size_t)(ch >> 5) * (M_ / 16) + (tok >> 4)) * 2 + ((tok >> 3) & 1)) * 32 + (ch & 31)) * 8 + (tok & 7); }
DI int sidx2(int row, int k) { return ((((row >> 5) * 8 + (k >> 4)) * 2 + ((k >> 3) & 1)) * 32 + (row & 31)) * 8 + (k & 7); }
DI float sigmoidf_(float x) { return __builtin_amdgcn_rcpf(1.f + __expf(-x)); }
DI float siluf_(float x) { return x * sigmoidf_(x); }
DI float softplusf_(float x) { return fmaxf(x, 0.f) + log1pf(__expf(-fabsf(x))); }
DI float logsigmoidf_(float x) { return fminf(x, 0.f) - log1pf(__expf(-fabsf(x))); }
DI float gelu_tanh(float y) { const float t = 0.7978845608028654f * (y + 0.044715f * y * y * y); const float th = 1.f - 2.f * __builtin_amdgcn_rcpf(__expf(2.f * t) + 1.f); return 0.5f * y * (1.f + th); }
DI bf16x8 as_bf16x8(u32x4 v) { return __builtin_bit_cast(bf16x8, v); }
DI bf16x8 ld_frag(const bf16_t* p) { return as_bf16x8(*(const u32x4*)p); }
DI bf16x8 ld_frag2(const bf16_t* p0, const bf16_t* p1) { u32x2 a = *(const u32x2*)p0, b = *(const u32x2*)p1; u32x4 v; v.x = a.x; v.y = a.y; v.z = b.x; v.w = b.y; return as_bf16x8(v); }
DI f32x16 zero16() { f32x16 z; for (int i = 0; i < 16; ++i) z[i] = 0.f; return z; }
DI bf16x8 pack_step(const f32x16& x, int s) { u32x4 v; v.x = pack2(x[8 * s], x[8 * s + 1]); v.y = pack2(x[8 * s + 2], x[8 * s + 3]); v.z = pack2(x[8 * s + 4], x[8 * s + 5]); v.w = pack2(x[8 * s + 6], x[8 * s + 7]); return as_bf16x8(v); }
DI float swap_pair(float v) { return __builtin_bit_cast(float, __builtin_amdgcn_mov_dpp(__builtin_bit_cast(int, v), 0xB1, 0xF, 0xF, true)); }
DI float half_reduce(float v) {
    v += __shfl_xor(v, 1); v += __shfl_xor(v, 2); v += __shfl_xor(v, 4); v += __shfl_xor(v, 8); v += __shfl_xor(v, 16); return v;
}

typedef float f32x4v __attribute__((ext_vector_type(4)));
namespace g8 {
constexpr int BM = 256, BKK = 64, HALF = 128, HT = HALF * BKK, SHM_B = 8 * HT * 2, NXCD = 8, WGM = 8;
DI int lds_byte(int r, int c) { const int st = (r >> 4) * 2 + (c >> 5), rr = r & 15, cc = c & 31, ob = rr * 64 + cc * 2; return st * 1024 + (ob ^ (((ob >> 9) & 1) << 5)); }
DI void stage_rc(int b, int& R, int& C) { const int st = b / 1024, sb = b % 1024, swz = sb ^ (((sb >> 9) & 1) << 5); R = (st >> 1) * 16 + swz / 64; C = (st & 1) * 32 + (swz % 64) / 2; }

template <class Epi>
DI void tile(const bf16_t* __restrict__ A, int lda, const bf16_t* __restrict__ Bt, int ldb, int K, int brow, int bcol, bool first, bool has_next, int nbrow, int nbcol, bf16_t* shm, const Epi& epi) {
#define SA(b, h) (shm + ((b) * 4 + (h)) * HT)
#define SB(b, h) (shm + ((b) * 4 + 2 + (h)) * HT)
#define STAGE(P, BASE, OFF, LD, br, kt) do { const bf16_t* _g = (BASE) + ((size_t)(br) * (LD) + (size_t)(kt) * BKK); \
    _Pragma("unroll") for (int _i = 0; _i < 2; ++_i) { \
      __builtin_amdgcn_global_load_lds((const unsigned*)(_g + OFF[_i]), (__attribute__((address_space(3))) unsigned*)((char*)(P) + tx * 16 + _i * 8192), 16, 0, 0); } } while (0)
#define LDA(dst, b, h) _Pragma("unroll") for (int m = 0; m < 4; ++m) _Pragma("unroll") for (int k = 0; k < 2; ++k) \
    dst[m][k] = *reinterpret_cast<const bf16x8*>((char*)SA(b, h) + lds_byte(wr * 64 + m * 16 + fr, k * 32 + fq * 8))
#define LDB(dst, b, h) _Pragma("unroll") for (int n = 0; n < 2; ++n) _Pragma("unroll") for (int k = 0; k < 2; ++k) \
    dst[n][k] = *reinterpret_cast<const bf16x8*>((char*)SB(b, h) + lds_byte(wc * 32 + n * 16 + fr, k * 32 + fq * 8))
#define MMA(ai, bj, At_, Bt_) do { __builtin_amdgcn_s_setprio(1); \
    _Pragma("unroll") for (int m = 0; m < 4; ++m) _Pragma("unroll") for (int n = 0; n < 2; ++n) _Pragma("unroll") for (int k = 0; k < 2; ++k) \
      acc[ai][bj][m][n] = __builtin_amdgcn_mfma_f32_16x16x32_bf16(At_[m][k], Bt_[n][k], acc[ai][bj][m][n], 0, 0, 0); \
    __builtin_amdgcn_s_setprio(0); } while (0)
#define WAIT_V(n) asm volatile("s_waitcnt vmcnt(" #n ")" ::: "memory")
#define WAIT_L(n) asm volatile("s_waitcnt lgkmcnt(" #n ")" ::: "memory")
#define BAR __builtin_amdgcn_s_barrier()
#define SCHED __builtin_amdgcn_sched_barrier(0)
    int tx = threadIdx.x;
    asm volatile("" : "+v"(tx));
    const int wid = tx >> 6, lane = tx & 63, wr = __builtin_amdgcn_readfirstlane(wid >> 2), wc = __builtin_amdgcn_readfirstlane(wid & 3), fr = lane & 15, fq = lane >> 4;
    unsigned offA[2], offB[2];
#pragma unroll
    for (int i = 0; i < 2; ++i) { int r_, c_; stage_rc(tx * 16 + i * 8192, r_, c_); offA[i] = (unsigned)(r_ * lda + c_); offB[i] = (unsigned)(r_ * ldb + c_); }
    f32x4v acc[2][2][4][2];
#pragma unroll
    for (int a = 0; a < 2; ++a)
#pragma unroll
        for (int b = 0; b < 2; ++b)
#pragma unroll
            for (int m = 0; m < 4; ++m)
#pragma unroll
                for (int n = 0; n < 2; ++n) acc[a][b][m][n] = (f32x4v){0.f, 0.f, 0.f, 0.f};
    bf16x8 At[4][2], B0[2][2], B1[2][2];
    const int nt = K / BKK;
    WAIT_V(0);
    if (first) {
        STAGE(SB(0, 0), Bt, offB, ldb, bcol, 0); STAGE(SA(0, 0), A, offA, lda, brow, 0);
        STAGE(SB(0, 1), Bt, offB, ldb, bcol + HALF, 0); STAGE(SA(0, 1), A, offA, lda, brow + HALF, 0);
    }
    if (wr == 1) BAR;
    if (first) WAIT_V(4);
    BAR;
    STAGE(SB(1, 0), Bt, offB, ldb, bcol, 1); STAGE(SA(1, 0), A, offA, lda, brow, 1); STAGE(SB(1, 1), Bt, offB, ldb, bcol + HALF, 1);
    WAIT_V(6); BAR;
#pragma unroll 1
    for (int t = 0; t < nt - 2; t += 2) {
        LDB(B0, 0, 0); SCHED; LDA(At, 0, 0); STAGE(SA(1, 1), A, offA, lda, brow + HALF, t + 1);
        WAIT_L(8); BAR; WAIT_L(0); MMA(0, 0, At, B0); BAR; SCHED;
        LDB(B1, 0, 1); STAGE(SB(0, 0), Bt, offB, ldb, bcol, t + 2);
        BAR; WAIT_L(0); MMA(0, 1, At, B1); BAR;
        LDA(At, 0, 1); STAGE(SA(0, 0), A, offA, lda, brow, t + 2);
        BAR; WAIT_L(0); MMA(1, 0, At, B0); BAR; SCHED;
        STAGE(SB(0, 1), Bt, offB, ldb, bcol + HALF, t + 2);
        WAIT_V(6); BAR; MMA(1, 1, At, B1); BAR;
        LDB(B0, 1, 0); SCHED; LDA(At, 1, 0); STAGE(SA(0, 1), A, offA, lda, brow + HALF, t + 2);
        WAIT_L(8); BAR; WAIT_L(0); MMA(0, 0, At, B0); BAR; SCHED;
        LDB(B1, 1, 1); STAGE(SB(1, 0), Bt, offB, ldb, bcol, t + 3);
        BAR; WAIT_L(0); MMA(0, 1, At, B1); BAR;
        LDA(At, 1, 1); STAGE(SA(1, 0), A, offA, lda, brow, t + 3);
        BAR; WAIT_L(0); MMA(1, 0, At, B0); BAR; SCHED;
        STAGE(SB(1, 1), Bt, offB, ldb, bcol + HALF, t + 3);
        WAIT_V(6); BAR; MMA(1, 1, At, B1); BAR;
    }
    { LDB(B0, 0, 0); LDA(At, 0, 0); STAGE(SA(1, 1), A, offA, lda, brow + HALF, nt - 1);
      BAR; WAIT_L(0); MMA(0, 0, At, B0); BAR;
      LDB(B1, 0, 1); BAR; WAIT_L(0); MMA(0, 1, At, B1); BAR;
      LDA(At, 0, 1); WAIT_V(4); BAR; WAIT_L(0); MMA(1, 0, At, B0); MMA(1, 1, At, B1); BAR; }
    { LDB(B0, 1, 0); LDA(At, 1, 0); WAIT_V(2); BAR; WAIT_L(0); MMA(0, 0, At, B0); BAR;
      LDB(B1, 1, 1); WAIT_V(0); BAR; WAIT_L(0); MMA(0, 1, At, B1); BAR;
      LDA(At, 1, 1); BAR; WAIT_L(0); MMA(1, 0, At, B0); MMA(1, 1, At, B1); BAR; }
    if (wr == 0) BAR;
    {
        int t2 = threadIdx.x;
        asm volatile("" : "+v"(t2));
        if (has_next) {
            unsigned oA[2], oB[2];
#pragma unroll
            for (int i = 0; i < 2; ++i) { int r_, c_; stage_rc(t2 * 16 + i * 8192, r_, c_); oA[i] = (unsigned)(r_ * lda + c_); oB[i] = (unsigned)(r_ * ldb + c_); }
            const int tx = t2;
            STAGE(SB(0, 0), Bt, oB, ldb, nbcol, 0); STAGE(SA(0, 0), A, oA, lda, nbrow, 0);
            STAGE(SB(0, 1), Bt, oB, ldb, nbcol + HALF, 0); STAGE(SA(0, 1), A, oA, lda, nbrow + HALF, 0);
        }
        float* stg = (float*)(shm + 4 * HT);
        const int wr2 = t2 >> 8, wc2 = (t2 >> 6) & 3, fr2 = t2 & 15, fq2 = (t2 >> 4) & 3;
#pragma unroll
        for (int q = 0; q < 4; ++q) {
            const int ai = q >> 1, bj = q & 1;
            typename Epi::Pre pre;
            epi.pre(pre, brow + ai * 128, bcol + bj * 128, t2);
#pragma unroll
            for (int m = 0; m < 4; ++m)
#pragma unroll
                for (int n = 0; n < 2; ++n)
#pragma unroll
                    for (int j = 0; j < 4; ++j)
                        stg[(wr2 * 64 + m * 16 + fq2 * 4 + j) * 128 + ((wc2 * 32 + n * 16 + fr2) ^ (fq2 << 4))] = acc[ai][bj][m][n][j];
            WAIT_L(0); BAR;
            epi.quarter(stg, brow + ai * 128, bcol + bj * 128, t2, pre);
            WAIT_L(0); BAR;
        }
    }
#undef SA
#undef SB
#undef STAGE
#undef LDA
#undef LDB
#undef MMA
#undef WAIT_V
#undef WAIT_L
#undef BAR
#undef SCHED
}

DI void tile_coords(int L, int nM, int nN, int& pm, int& pn) {
    const int nwg = nM * nN;
    int wgid = L;
    { const int q = nwg / NXCD, r = nwg % NXCD, xcd = wgid % NXCD, off = wgid / NXCD; wgid = (xcd < r ? xcd * (q + 1) : r * (q + 1) + (xcd - r) * q) + off; }
    const int nig = WGM * nN, gid = wgid / nig, fm = gid * WGM, gsz = (nM - fm) < WGM ? (nM - fm) : WGM;
    pm = fm + ((wgid % nig) % gsz); pn = (wgid % nig) / gsz;
}
template <class Epi>
DI void phase(const bf16_t* A, int lda, const bf16_t* Bt, int ldb, int K, int Mrows, int Ncols, bf16_t* shm, const Epi& epi) {
    const int nM = Mrows / BM, nN = Ncols / BM, nwg = nM * nN;
    bool first = true;
    for (int L = blockIdx.x; L < nwg; L += gridDim.x) {
        int pm, pn, qm = 0, qn = 0;
        tile_coords(L, nM, nN, pm, pn);
        const bool has_next = (L + (int)gridDim.x) < nwg;
        if (has_next) tile_coords(L + gridDim.x, nM, nN, qm, qn);
        tile(A, lda, Bt, ldb, K, pm * BM, pn * BM, first, has_next, qm * BM, qn * BM, shm, epi);
        first = false;
    }
    asm volatile("s_waitcnt vmcnt(0)" ::: "memory");
}
}

DI int sidx(int rl, int c) { return rl * 128 + (c ^ (((rl >> 2) & 3) << 4)); }
DI u32x4 pack8(const f32x4& a, const f32x4& b) { u32x4 v; v.x = pack2(a[0], a[1]); v.y = pack2(a[2], a[3]); v.z = pack2(b[0], b[1]); v.w = pack2(b[2], b[3]); return v; }
DI void quarter_store_bf16(const float* stg, bf16_t* dst, int ld, int r0, int cdst, float scale, int t) {
    const int c8 = (t & 15) * 8;
#pragma unroll 2
    for (int i = 0; i < 4; ++i) {
        const int rl = (t >> 4) + 32 * i;
        f32x4 a = *(const f32x4*)(stg + sidx(rl, c8)), b = *(const f32x4*)(stg + sidx(rl, c8 + 4));
        a *= scale; b *= scale;
        *(u32x4*)(dst + (size_t)(r0 + rl) * ld + cdst + c8) = pack8(a, b);
    }
}
DI void quarter_store_T(const float* stg, bf16_t* dstT, int ch0, int r0, bf16_t* halo, int t) {
    const int col = t & 127;
#pragma unroll 2
    for (int i = 0; i < 4; ++i) {
        const int r8 = (t >> 7) + 4 * i;
        float v[8];
#pragma unroll
        for (int jj = 0; jj < 8; ++jj) v[jj] = stg[sidx(8 * r8 + jj, col)];
        u32x4 pk; pk.x = pack2(v[0], v[1]); pk.y = pack2(v[2], v[3]); pk.z = pack2(v[4], v[5]); pk.w = pack2(v[6], v[7]);
        *(u32x4*)(dstT + tidx(ch0 + col, r0 + 8 * r8)) = pk;
        if (halo && r8 == 15) { u32x2 h; h.x = pk.z; h.y = pk.w; *(u32x2*)(halo + ((size_t)(r0 >> 7) * 1024 + ch0 + col) * 4) = h; }
    }
}
struct EpiInProj {
    struct Pre {}; DI void pre(Pre&, int, int, int) const {}
    bf16_t *z, *xT, *btm, *ctm, *q, *k, *vT, *r, *xhalo, *bchalo; float *dt, *ga; const float* dt_bias;
    DI void quarter(const float* stg, int r0, int c0, int t, const Pre& pre) const {
        if (c0 < 1024) quarter_store_bf16(stg, z, 1024, r0, c0, 1.f, t);
        else if (c0 < 2048) quarter_store_T(stg, xT, c0 - 1024, r0, xhalo, t);
        else if (c0 < 2560) {
            const int cb = c0 - 2048;
            quarter_store_bf16(stg, cb < 256 ? btm : ctm, 256, r0, cb & 255, 1.f, t);
            if (t < 64) {
                const int rl = 124 + (t >> 4), c8 = (t & 15) * 8;
                const f32x4 a = *(const f32x4*)(stg + sidx(rl, c8)), b = *(const f32x4*)(stg + sidx(rl, c8 + 4));
                *(u32x4*)(bchalo + ((size_t)(r0 >> 7) * 4 + (t >> 4)) * 512 + cb + c8) = pack8(a, b);
            }
        }
        else if (c0 < 3072) quarter_store_bf16(stg, q, 512, r0, c0 - 2560, 0.08838834764831845f, t);
        else if (c0 < 3584) quarter_store_bf16(stg, k, 512, r0, c0 - 3072, 1.f, t);
        else if (c0 < 4608) quarter_store_T(stg, vT, c0 - 3584, r0, nullptr, t);
        else if (c0 < 5632) quarter_store_bf16(stg, r, 1024, r0, c0 - 4608, 1.f, t);
        else if (c0 == 5632) {
            int tt = t;
            asm volatile("" : "+v"(tt));
            const int c = tt & 31;
            const float bias = c < 16 ? dt_bias[c] : 0.f;
#pragma unroll 2
            for (int i = 0; i < 8; ++i) {
                const int rl = (tt >> 5) + 16 * i;
                const float v = stg[sidx(rl, c)];
                if (c < 16) dt[(size_t)(r0 + rl) * 16 + c] = softplusf_(v + bias);
                else ga[(size_t)(r0 + rl) * 16 + c - 16] = v;
            }
        }
    }
};

template <int MODE>
struct EpiResidual {
    float* U; const float* X; const float* ssq;
    struct Pre { f32x4 x[4][2]; };
    DI void pre(Pre& P, int r0, int c0, int t) const {
        const float* src = (MODE == 0) ? X : U;
        const int c8 = (t & 15) * 8;
#pragma unroll
        for (int i = 0; i < 4; ++i) { const size_t idx = (size_t)(r0 + (t >> 4) + 32 * i) * 1024 + c0 + c8; P.x[i][0] = *(const f32x4*)(src + idx); P.x[i][1] = *(const f32x4*)(src + idx + 4); }
    }
    DI void quarter(const float* stg, int r0, int c0, int t, const Pre& pre) const {
        const int c8 = (t & 15) * 8;
#pragma unroll
        for (int i = 0; i < 4; ++i) {
            const int rl = (t >> 4) + 32 * i;
            const f32x4 a = *(const f32x4*)(stg + sidx(rl, c8)), b = *(const f32x4*)(stg + sidx(rl, c8 + 4));
            const size_t idx = (size_t)(r0 + rl) * 1024 + c0 + c8;
            if (MODE == 0) {
                const f32x4 xa = pre.x[i][0], xb2 = pre.x[i][1];
                *(f32x4*)(U + idx) = xa * DN_ALPHA + a; *(f32x4*)(U + idx + 4) = xb2 * DN_ALPHA + b;
            } else {
                const float sc = rsqrtf(ssq[r0 + rl] * (1.f / 1024.f) + LN_EPS);
                const f32x4 ua = pre.x[i][0], ub = pre.x[i][1];
                *(f32x4*)(U + idx) = ua + a * sc; *(f32x4*)(U + idx + 4) = ub + b * sc;
            }
        }
    }
};

struct EpiSwiGLU {
    struct Pre {}; DI void pre(Pre&, int, int, int) const {}
    bf16_t* hmid;
    DI void quarter(const float* stg, int r0, int c0, int t, const Pre& pre) const {
        const int u8 = (t & 7) * 8, cg = (u8 >> 4) * 32 + (u8 & 15);
#pragma unroll 1
        for (int i = 0; i < 2; ++i) {
            const int rl = (t >> 3) + 64 * i;
            const f32x4 g0 = *(const f32x4*)(stg + sidx(rl, cg)), g1 = *(const f32x4*)(stg + sidx(rl, cg + 4)), u0 = *(const f32x4*)(stg + sidx(rl, cg + 16)), u1 = *(const f32x4*)(stg + sidx(rl, cg + 20));
            f32x4 o0, o1;
#pragma unroll
            for (int e = 0; e < 4; ++e) { o0[e] = siluf_(g0[e]) * u0[e]; o1[e] = siluf_(g1[e]) * u1[e]; }
            *(u32x4*)(hmid + (size_t)(r0 + rl) * FFH + (c0 >> 1) + u8) = pack8(o0, o1);
        }
    }
};
struct EpiGLU {
    struct Pre { f32x4 u[2][2]; };
    DI void pre(Pre& P, int r0, int c0, int t) const {
        const int u8 = (t & 7) * 8, unit = (c0 >> 1) + u8;
#pragma unroll
        for (int i = 0; i < 2; ++i) { const size_t idx = (size_t)(r0 + (t >> 3) + 64 * i) * 1024 + unit; P.u[i][0] = *(const f32x4*)(U + idx); P.u[i][1] = *(const f32x4*)(U + idx + 4); }
    }
    float* U; const float *ba, *bb;
    DI void quarter(const float* stg, int r0, int c0, int t, const Pre& pre) const {
        const int u8 = (t & 7) * 8, cg = (u8 >> 4) * 32 + (u8 & 15);
        const int unit = (c0 >> 1) + u8;
        const f32x4 ba0 = *(const f32x4*)(ba + unit), ba1 = *(const f32x4*)(ba + unit + 4), bb0 = *(const f32x4*)(bb + unit), bb1 = *(const f32x4*)(bb + unit + 4);
#pragma unroll
        for (int i = 0; i < 2; ++i) {
            const int rl = (t >> 3) + 64 * i;
            const f32x4 a0 = *(const f32x4*)(stg + sidx(rl, cg)), a1 = *(const f32x4*)(stg + sidx(rl, cg + 4)), b0 = *(const f32x4*)(stg + sidx(rl, cg + 16)), b1 = *(const f32x4*)(stg + sidx(rl, cg + 20));
            const size_t idx = (size_t)(r0 + rl) * 1024 + unit;
            f32x4 o0 = pre.u[i][0], o1 = pre.u[i][1];
#pragma unroll
            for (int e = 0; e < 4; ++e) {
                o0[e] = DN_ALPHA * o0[e] + (a0[e] + ba0[e]) * sigmoidf_(b0[e] + bb0[e]);
                o1[e] = DN_ALPHA * o1[e] + (a1[e] + ba1[e]) * sigmoidf_(b1[e] + bb1[e]);
            }
            *(f32x4*)(U + idx) = o0; *(f32x4*)(U + idx + 4) = o1;
        }
    }
};

struct ColSrc { const float* p; int ld; };
template <class MapFn>
DI void prep_wt_units(bf16_t* dst, int Nd, int K, const MapFn& mapfn, float* lds, int vb0, int nvb) {
    const int T_ = opaque_tid();
    const int nkt = K / 64, nun = (Nd / 64) * nkt;
    const int tid = VTID;
    const int nn_l = tid & 63, kq_l = tid >> 6;
    float vals[16];
    int uu = vb0;
    if (uu < nun) {
        const int nt = uu / nkt, kt = uu % nkt;
        const ColSrc cs = mapfn(nt * 64 + nn_l);
#pragma unroll
        for (int i = 0; i < 16; ++i) vals[i] = cs.p ? cs.p[(size_t)(kt * 64 + i * 4 + kq_l) * cs.ld] : 0.f;
    }
    for (; uu < nun; uu += nvb) {
        const int nt = uu / nkt, kt = uu % nkt, n0 = nt * 64, k0 = kt * 64;
#pragma unroll
        for (int i = 0; i < 16; ++i) lds[(i * 4 + kq_l) * 65 + nn_l] = vals[i];
        __syncthreads();
        const int un = uu + nvb;
        if (un < nun) {
            const int nt2 = un / nkt, kt2 = un % nkt;
            const ColSrc cs = mapfn(nt2 * 64 + nn_l);
#pragma unroll
            for (int i = 0; i < 16; ++i) vals[i] = cs.p ? cs.p[(size_t)(kt2 * 64 + i * 4 + kq_l) * cs.ld] : 0.f;
        }
        {
            const int nn = tid >> 2, kq = tid & 3;
            u32x4 v0, v1;
            const float* sp = lds + (kq * 16) * 65 + nn;
            v0.x = pack2(sp[0 * 65], sp[1 * 65]); v0.y = pack2(sp[2 * 65], sp[3 * 65]); v0.z = pack2(sp[4 * 65], sp[5 * 65]); v0.w = pack2(sp[6 * 65], sp[7 * 65]);
            v1.x = pack2(sp[8 * 65], sp[9 * 65]); v1.y = pack2(sp[10 * 65], sp[11 * 65]); v1.z = pack2(sp[12 * 65], sp[13 * 65]); v1.w = pack2(sp[14 * 65], sp[15 * 65]);
            bf16_t* d = dst + (size_t)(n0 + nn) * K + k0 + kq * 16;
            *(u32x4*)d = v0; *(u32x4*)(d + 8) = v1;
        }
        __syncthreads();
    }
}

struct MapIn { const float* w;
    DI ColSrc operator()(int n) const {
        int src;
        if (n < 2560) src = n; else if (n < 3072) src = 2576 + (n - 2560); else if (n < 3584) src = 3088 + (n - 3072);
        else if (n < 4608) src = 3600 + (n - 3584); else if (n < 5632) src = 4624 + (n - 4608); else if (n < 5648) src = 2560 + (n - 5632);
        else if (n < 5664) src = n; else return ColSrc{nullptr, 0};
        return ColSrc{w + src, 5664};
    } };
struct MapPlain { const float* w; int ld; DI ColSrc operator()(int n) const { return ColSrc{w + n, ld}; } };
struct MapPair { const float *wa, *wb; int ld;
    DI ColSrc operator()(int n) const { const int unit = (n >> 5) * 16 + (n & 15); return ColSrc{((n >> 4) & 1) ? wb + unit : wa + unit, ld}; } };

DI void phase_prep0(const Params& p, unsigned char* smem) {
    const int T_ = opaque_tid();
    float* lds = (float*)(smem + VB * VB_LDS);
    unsigned char* ws = p.ws;
    prep_wt_units((bf16_t*)(ws + OFF_WT_IN), NIN, 1024, MapIn{p.in[1]}, lds, 2 * blockIdx.x + VB, 2 * gridDim.x);
    prep_wt_units((bf16_t*)(ws + OFF_WT_OUT), 1024, 2048, MapPlain{p.in[11], 1024}, lds, 2 * blockIdx.x + VB, 2 * gridDim.x);
    prep_wt_units((bf16_t*)(ws + OFF_WT_GU0), 5632, 1024, MapPair{p.in[14], p.in[15], FFH}, lds, 2 * blockIdx.x + VB, 2 * gridDim.x);
    prep_wt_units((bf16_t*)(ws + OFF_WT_DN0), 1024, 2816, MapPlain{p.in[16], 1024}, lds, 2 * blockIdx.x + VB, 2 * gridDim.x);
    for (int e = blockIdx.x * NT + T_; e < 64 * 64; e += gridDim.x * NT) {
        const int pp = e & 63, g = e >> 6, q = pp >> 5, lr = pp & 31;
        const float step = __expf(p.in[21][g]);
        const float ar = p.in[19][e], ai = p.in[20][e];
        const float mag = expf(ar * step);
        float sn, cs; sincosf(ai * step, &sn, &cs);
        const float abr = mag * cs, abi = mag * sn;
        float* ab = (float*)(ws + OFF_S5AB); ab[e * 2] = abr; ab[e * 2 + 1] = abi;
        const float nr = abr - 1.f, den = ar * ar + ai * ai;
        const float fr = (nr * ar + abi * ai) / den, fi = (abi * ar - nr * ai) / den;
        bf16_t* bb = (bf16_t*)(ws + OFF_S5BB);
        for (int c = 0; c < 16; ++c) {
            const float br = p.in[22][(size_t)e * 16 + c], bi = p.in[23][(size_t)e * 16 + c];
            const int lh = c >> 3, j = c & 7;
            bb[((((size_t)g * 4 + 2 * q) * 2 + lh) * 32 + lr) * 8 + j] = f2bf(fr * br - fi * bi);
            bb[((((size_t)g * 4 + 2 * q + 1) * 2 + lh) * 32 + lr) * 8 + j] = f2bf(fr * bi + fi * br);
        }
    }
    for (int e = blockIdx.x * NT + T_; e < 64 * 4 * 4 * 16 * 8; e += gridDim.x * NT) {
        const int j = e & 7, c = (e >> 3) & 15, lq = (e >> 7) & 3, ks4 = (e >> 9) & 3, g = e >> 11;
        const int k = ks4 * 32 + lq * 8 + j, st = k >> 1, comp = k & 1;
        const float v = comp ? -p.in[25][(size_t)(g * 16 + c) * 64 + st] : p.in[24][(size_t)(g * 16 + c) * 64 + st];
        ((bf16_t*)(ws + OFF_S5CM))[e] = f2bf(v);
    }
    const float* x = p.in[0];
    bf16_t* xb = (bf16_t*)p.out;
    const size_t n8 = (size_t)M_ * 1024 / 8;
    for (size_t i = (size_t)blockIdx.x * NT + T_; i < n8; i += (size_t)gridDim.x * NT) {
        const f32x4 a = *(const f32x4*)(x + i * 8), b = *(const f32x4*)(x + i * 8 + 4);
        u32x4 v; v.x = pack2(a[0], a[1]); v.y = pack2(a[2], a[3]); v.z = pack2(b[0], b[1]); v.w = pack2(b[2], b[3]);
        *(u32x4*)(xb + i * 8) = v;
    }
}
DI void prep_w1(const Params& p, unsigned char* smem, int first_wg) {
    const int T_ = opaque_tid();
    if ((int)blockIdx.x < first_wg) return;
    const int vb0 = 2 * ((int)blockIdx.x - first_wg) + VB, nvb = 2 * ((int)gridDim.x - first_wg);
    float* lds = (float*)(smem + VB * VB_LDS);
    unsigned char* ws = p.ws;
    prep_wt_units((bf16_t*)(ws + OFF_WT_GLU), 2048, 1024, MapPair{p.in[27], p.in[29], 1024}, lds, vb0, nvb);
    prep_wt_units((bf16_t*)(ws + OFF_WT_GU1), 5632, 1024, MapPair{p.in[33], p.in[34], FFH}, lds, vb0, nvb);
    prep_wt_units((bf16_t*)(ws + OFF_WT_DN1), 1024, 2816, MapPlain{p.in[35], 1024}, lds, vb0, nvb);
}

DI void phase_conv_gates(const Params& p, unsigned char* smem) {
    const int T_ = opaque_tid();
    unsigned char* ws = p.ws;
    const int tid = VTID;
    const float* conv_w = p.in[2]; const float* conv_b = p.in[3];
    bf16_t* xT = (bf16_t*)(ws + OFF_XT);
    const bf16_t* xhalo = (const bf16_t*)(ws + OFF_XHALO);
    constexpr int U1 = 4096, U2 = 512, U3 = 128, U4 = 2048;
    for (int u = 2 * blockIdx.x + VB; u < U1 + U2 + U3 + U4; u += 2 * gridDim.x) {
        if (u < U1) {
            const int chb = u & 31, tile = u >> 5, t0 = tile * 128;
            const int ch = chb * 32 + (tid & 31);
            u32x4 cur[2]; u32x2 prev[2];
#pragma unroll
            for (int i = 0; i < 2; ++i) {
                const int seg = (tid >> 5) + 8 * i;
                cur[i] = *(const u32x4*)(xT + tidx(ch, t0 + seg * 8));
                prev[i].x = 0; prev[i].y = 0;
                if (seg > 0) prev[i] = *(const u32x2*)(xT + tidx(ch, t0 + seg * 8 - 8) + 4);
                else if ((tile & 63) != 0) prev[i] = *(const u32x2*)(xhalo + ((size_t)(tile - 1) * 1024 + ch) * 4);
            }
            __syncthreads();
            const float w0 = conv_w[ch], w1 = conv_w[1536 + ch], w2 = conv_w[2 * 1536 + ch], w3 = conv_w[3 * 1536 + ch], bb = conv_b[ch];
#pragma unroll
            for (int i = 0; i < 2; ++i) {
                const int seg = (tid >> 5) + 8 * i;
                float xv[11];
                xv[0] = bfhi(prev[i].x); xv[1] = bflo(prev[i].y); xv[2] = bfhi(prev[i].y);
                xv[3] = bflo(cur[i].x); xv[4] = bfhi(cur[i].x); xv[5] = bflo(cur[i].y); xv[6] = bfhi(cur[i].y); xv[7] = bflo(cur[i].z); xv[8] = bfhi(cur[i].z); xv[9] = bflo(cur[i].w); xv[10] = bfhi(cur[i].w);
                float o[8];
#pragma unroll
                for (int e = 0; e < 8; ++e) o[e] = siluf_(bb + w0 * xv[e] + w1 * xv[e + 1] + w2 * xv[e + 2] + w3 * xv[e + 3]);
                u32x4 ov; ov.x = pack2(o[0], o[1]); ov.y = pack2(o[2], o[3]); ov.z = pack2(o[4], o[5]); ov.w = pack2(o[6], o[7]);
                *(u32x4*)(xT + tidx(ch, t0 + seg * 8)) = ov;
            }
        } else if (u < U1 + U2) {
            const int uu = u - U1, tile = uu >> 2, cblk = uu & 3, t0 = tile * 128;
            const int seg = tid >> 4, cg = tid & 15, cb = cblk * 128 + cg * 8;
            bf16_t* arr = (bf16_t*)(ws + (cb < 256 ? OFF_BTM : OFF_CTM));
            const int col = cb & 255;
            const bf16_t* bchalo = (const bf16_t*)(ws + OFF_BCHALO);
            u32x4 rows[11];
#pragma unroll
            for (int i = 0; i < 11; ++i) {
                const int tl = seg * 8 - 3 + i;
                if (tl >= 0) rows[i] = *(const u32x4*)(arr + (size_t)(t0 + tl) * 256 + col);
                else if ((tile & 63) != 0) rows[i] = *(const u32x4*)(bchalo + ((size_t)(tile - 1) * 4 + (4 + tl)) * 512 + cb);
                else { rows[i].x = 0; rows[i].y = 0; rows[i].z = 0; rows[i].w = 0; }
            }
            __syncthreads();
            u32x4 outr[8];
#pragma unroll
            for (int c2 = 0; c2 < 4; ++c2) {
                float wv[2][4], bv[2];
#pragma unroll
                for (int e = 0; e < 2; ++e) { const int cc = 1024 + cb + c2 * 2 + e; bv[e] = conv_b[cc];
#pragma unroll
                    for (int k = 0; k < 4; ++k) wv[e][k] = conv_w[k * 1536 + cc]; }
#pragma unroll
                for (int t = 0; t < 8; ++t) {
                    float o2[2];
#pragma unroll
                    for (int e = 0; e < 2; ++e) {
                        float s = bv[e];
#pragma unroll
                        for (int k = 0; k < 4; ++k) { const unsigned wd = rows[t + k][c2]; s += wv[e][k] * (e ? bfhi(wd) : bflo(wd)); }
                        o2[e] = siluf_(s);
                    }
                    outr[t][c2] = pack2(o2[0], o2[1]);
                }
            }
#pragma unroll
            for (int t = 0; t < 8; ++t) *(u32x4*)(arr + (size_t)(t0 + seg * 8 + t) * 256 + col) = outr[t];
            if (cb < 256) {
                bf16_t* BT = (bf16_t*)(ws + OFF_BT);
#pragma unroll
                for (int c = 0; c < 8; ++c) {
                    u32x4 v;
#pragma unroll
                    for (int tp = 0; tp < 4; ++tp) {
                        const unsigned lo = (outr[2 * tp][c >> 1] >> (16 * (c & 1))) & 0xffffu, hi = (outr[2 * tp + 1][c >> 1] >> (16 * (c & 1))) & 0xffffu;
                        v[tp] = lo | (hi << 16);
                    }
                    *(u32x4*)(BT + tidx(col + c, t0 + seg * 8)) = v;
                }
            }
        } else if (u < U1 + U2 + U3) {
            const int cc = u - U1 - U2, t0 = cc * 128;
            const int h = tid & 15, seg = tid >> 4;
            float* lds = (float*)(smem + VB * VB_LDS);
            const float* dt = (const float*)(ws + OFF_DT);
            float* dac = (float*)(ws + OFF_DAC); float* wst = (float*)(ws + OFF_WST); float* ssq = (float*)(ws + OFF_SSQ); float* cdec = (float*)(ws + OFF_CDEC);
            const float A = -__expf(p.in[5][h]);
            float dtv[8], cum[8]; float run = 0.f;
#pragma unroll
            for (int i = 0; i < 8; ++i) { dtv[i] = dt[(size_t)(t0 + seg * 8 + i) * 16 + h]; run += dtv[i] * A; cum[i] = run; }
            __syncthreads();
            lds[seg * 16 + h] = run;
            __syncthreads();
            float pre = 0.f, tot = 0.f;
            for (int s2 = 0; s2 < 16; ++s2) { const float v = lds[s2 * 16 + h]; if (s2 < seg) pre += v; tot += v; }
#pragma unroll
            for (int i = 0; i < 8; ++i) {
                const float c = pre + cum[i];
                dac[(size_t)(t0 + seg * 8 + i) * 16 + h] = c;
                wst[(size_t)h * M_ + t0 + seg * 8 + i] = dtv[i] * __expf(tot - c);
            }
            if (seg == 0) cdec[cc * 16 + h] = __expf(tot);
            if (tid < 128) ssq[t0 + tid] = 0.f;
        } else {
            const int uu = u - U1 - U2 - U3, cc = uu >> 4, cb = uu & 15, t0 = cc * 128;
            const int ch = cb * 32 + (tid & 31), seg = tid >> 5;
            float* lds = (float*)(smem + VB * VB_LDS);
            const float* ga = (const float*)(ws + OFF_GA);
            __syncthreads();
            for (int i = tid; i < 128 * 16; i += NTHREADS) lds[i] = ga[(size_t)t0 * 16 + i];
            __syncthreads();
            float wg[16];
#pragma unroll
            for (int r = 0; r < 16; ++r) wg[r] = p.in[8][r * 512 + ch];
            const float bg = p.in[9][ch];
            float la[16], run = 0.f;
#pragma unroll
            for (int i = 0; i < 16; ++i) {
                const int t = seg * 16 + i;
                float xg = bg;
#pragma unroll
                for (int r = 0; r < 16; ++r) xg += lds[t * 16 + r] * wg[r];
                la[i] = (fminf(xg, 0.f) - __logf(1.f + __expf(-fabsf(xg)))) * (1.f / 16.f);
                run += la[i];
            }
            lds[2048 + seg * 32 + (tid & 31)] = run;
            __syncthreads();
            float pre = 0.f, Gref = 0.f, Glast = 0.f;
#pragma unroll
            for (int s2 = 0; s2 < 8; ++s2) { const float v = lds[2048 + s2 * 32 + (tid & 31)]; if (s2 < seg) pre += v; if (s2 < 4) Gref += v; Glast += v; }
            if (seg == 0) {
                ((float*)(ws + OFF_GREF))[cc * 512 + ch] = __expf(Gref);
                ((float*)(ws + OFF_GLAST))[cc * 512 + ch] = __expf(Glast);
                ((float*)(ws + OFF_CSC))[cc * 512 + ch] = __expf(Glast - Gref);
            }
            bf16_t* q = (bf16_t*)(ws + OFF_Q); bf16_t* k = (bf16_t*)(ws + OFF_K); bf16_t* kT = (bf16_t*)(ws + OFF_KT);
            float G = pre, kk[16], eq[16], ek[16];
#pragma unroll
            for (int i = 0; i < 16; ++i) { G += la[i]; eq[i] = __expf(G - Gref); ek[i] = __expf(Gref - G); }
            const int par = tid & 1;
#pragma unroll
            for (int k2 = 0; k2 < 8; ++k2) {
                const float eqp = swap_pair(par ? eq[2 * k2] : eq[2 * k2 + 1]), ekp = swap_pair(par ? ek[2 * k2] : ek[2 * k2 + 1]);
                const float eq_lo = par ? eqp : eq[2 * k2], eq_hi = par ? eq[2 * k2 + 1] : eqp;
                const float ek_lo = par ? ekp : ek[2 * k2], ek_hi = par ? ek[2 * k2 + 1] : ekp;
                const size_t idx = (size_t)(t0 + seg * 16 + 2 * k2 + par) * 512 + (ch & ~1);
                const unsigned uq = *(const unsigned*)(q + idx), uk = *(const unsigned*)(k + idx);
                const float klo = bflo(uk) * ek_lo, khi = bfhi(uk) * ek_hi;
                *(unsigned*)(q + idx) = pack2(bflo(uq) * eq_lo, bfhi(uq) * eq_hi);
                *(unsigned*)(k + idx) = pack2(klo, khi);
                const float back = swap_pair(par ? klo : khi);
                kk[2 * k2] = par ? back : klo; kk[2 * k2 + 1] = par ? khi : back;
            }
            u32x4 v0, v1;
            v0.x = pack2(kk[0], kk[1]); v0.y = pack2(kk[2], kk[3]); v0.z = pack2(kk[4], kk[5]); v0.w = pack2(kk[6], kk[7]);
            v1.x = pack2(kk[8], kk[9]); v1.y = pack2(kk[10], kk[11]); v1.z = pack2(kk[12], kk[13]); v1.w = pack2(kk[14], kk[15]);
            *(u32x4*)(kT + tidx(ch, t0 + seg * 16)) = v0; *(u32x4*)(kT + tidx(ch, t0 + seg * 16 + 8)) = v1;
        }
    }
}

DI void phase_states(const Params& p) {
    const int T_ = opaque_tid();
    unsigned char* ws = p.ws;
    const int tid = VTID, lane = tid & 63, w = tid >> 6, lr = lane & 31, lh = lane >> 5;
    const bf16_t* xT = (const bf16_t*)(ws + OFF_XT); const bf16_t* BT = (const bf16_t*)(ws + OFF_BT);
    const float* wst = (const float*)(ws + OFF_WST);
    const bf16_t* vT = (const bf16_t*)(ws + OFF_VT); const bf16_t* kT = (const bf16_t*)(ws + OFF_KT);
    bf16_t* sst = (bf16_t*)p.out;
    bf16_t* gst = (bf16_t*)((unsigned char*)p.out + OUT_HALF);
    constexpr int U1 = 2048, U2 = 1024;
    for (int u = 2 * blockIdx.x + VB; u < U1 + U2; u += 2 * gridDim.x) {
        if (u < U1) {
            const int h = u & 15, cc = u >> 4, g = h >> 3, t0 = cc * 128;
            f32x16 acc[2] = {zero16(), zero16()};
#pragma unroll
            for (int ks = 0; ks < 8; ++ks) {
                const int tk = t0 + ks * 16 + 8 * lh;
                const bf16x8 b = ld_frag(BT + tidx(g * 128 + w * 32 + lr, tk));
                const f32x4 s0 = *(const f32x4*)(wst + (size_t)h * M_ + tk), s1 = *(const f32x4*)(wst + (size_t)h * M_ + tk + 4);
#pragma unroll
                for (int mi = 0; mi < 2; ++mi) {
                    const u32x4 xa = *(const u32x4*)(xT + tidx(h * 64 + mi * 32 + lr, tk));
                    u32x4 xs;
                    xs.x = pack2(bflo(xa.x) * s0[0], bfhi(xa.x) * s0[1]); xs.y = pack2(bflo(xa.y) * s0[2], bfhi(xa.y) * s0[3]);
                    xs.z = pack2(bflo(xa.z) * s1[0], bfhi(xa.z) * s1[1]); xs.w = pack2(bflo(xa.w) * s1[2], bfhi(xa.w) * s1[3]);
                    acc[mi] = MFMA(b, as_bf16x8(xs), acc[mi]);
                }
            }
            bf16_t* dst = sst + (size_t)(cc * 16 + h) * 64 * 128;
#pragma unroll
            for (int mi = 0; mi < 2; ++mi)
#pragma unroll
                for (int gq = 0; gq < 4; ++gq) { u32x2 v; v.x = pack2(acc[mi][4 * gq], acc[mi][4 * gq + 1]); v.y = pack2(acc[mi][4 * gq + 2], acc[mi][4 * gq + 3]);
                    *(u32x2*)(dst + sidx2(mi * 32 + lr, w * 32 + 8 * gq + 4 * lh)) = v; }
        } else {
            const int uu = u - U1, vh = uu & 1, hd = (uu >> 1) & 3, cc = uu >> 3, t0 = cc * 128;
            f32x16 acc[4] = {zero16(), zero16(), zero16(), zero16()};
            const int vrow = hd * 256 + vh * 128 + w * 32;
#pragma unroll
            for (int ks = 0; ks < 8; ++ks) {
                const int tk = t0 + ks * 16 + 8 * lh;
                const bf16x8 a = ld_frag(vT + tidx(vrow + lr, tk));
#pragma unroll
                for (int ni = 0; ni < 4; ++ni) {
                    const bf16x8 b = ld_frag(kT + tidx(hd * 128 + ni * 32 + lr, tk));
                    acc[ni] = MFMA(b, a, acc[ni]);
                }
            }
            bf16_t* dst = gst + (size_t)(cc * 4 + hd) * 256 * 128;
#pragma unroll
            for (int ni = 0; ni < 4; ++ni)
#pragma unroll
                for (int gq = 0; gq < 4; ++gq) { u32x2 v; v.x = pack2(acc[ni][4 * gq], acc[ni][4 * gq + 1]); v.y = pack2(acc[ni][4 * gq + 2], acc[ni][4 * gq + 3]);
                    *(u32x2*)(dst + sidx2(vh * 128 + w * 32 + lr, ni * 32 + 8 * gq + 4 * lh)) = v; }
        }
    }
}

DI void phase_carry(const Params& p) {
    const int T_ = opaque_tid();
    unsigned char* ws = p.ws;
    unsigned* sst = (unsigned*)p.out;
    unsigned* gst = (unsigned*)((unsigned char*)p.out + OUT_HALF);
    const float* cdec = (const float*)(ws + OFF_CDEC);
    const float* gref = (const float*)(ws + OFF_GREF); const float* glast = (const float*)(ws + OFF_GLAST); const float* csc = (const float*)(ws + OFF_CSC);
    constexpr int NE = 131072;
    for (int e = blockIdx.x * NT + T_; e < 2 * NE; e += gridDim.x * NT) {
        if (e < NE) {
            const int m = e & 4095, h = (e >> 12) & 15, b = e >> 16;
            float a0 = 0.f, a1 = 0.f;
#pragma unroll 8
            for (int c = 0; c < 64; ++c) {
                const int cc = b * 64 + c;
                unsigned* ptr = sst + (size_t)(cc * 16 + h) * 4096 + m;
                const unsigned s = *ptr;
                *ptr = pack2(a0, a1);
                const float d = cdec[cc * 16 + h];
                a0 = d * a0 + bflo(s); a1 = d * a1 + bfhi(s);
            }
        } else {
            const int e2 = e - NE;
            const int m = e2 & 16383, hd = (e2 >> 14) & 3, b = e2 >> 16;
            const int off = 2 * m, dd = ((off >> 9) & 7) * 16 + ((off >> 8) & 1) * 8 + (off & 7);
            float a0 = 0.f, a1 = 0.f;
#pragma unroll 8
            for (int c = 0; c < 64; ++c) {
                const int cc = b * 64 + c;
                unsigned* ptr = gst + (size_t)(cc * 4 + hd) * 16384 + m;
                const unsigned s = *ptr;
                const int fi = cc * 512 + hd * 128 + dd;
                *ptr = pack2(a0 * gref[fi], a1 * gref[fi + 1]);
                a0 = glast[fi] * a0 + csc[fi] * bflo(s); a1 = glast[fi + 1] * a1 + csc[fi + 1] * bfhi(s);
            }
        }
    }
}

DI void phase_mixer_out(const Params& p, unsigned char* smem) {
    const int T_ = opaque_tid();
    unsigned char* ws = p.ws;
    float* lds = (float*)(smem + VB * VB_LDS);
    const bf16_t* xT = (const bf16_t*)(ws + OFF_XT); const bf16_t* btm = (const bf16_t*)(ws + OFF_BTM); const bf16_t* ctm = (const bf16_t*)(ws + OFF_CTM);
    const float* dtp = (const float*)(ws + OFF_DT); const float* dac = (const float*)(ws + OFF_DAC);
    float* ssq = (float*)(ws + OFF_SSQ);
    bf16_t* zb = (bf16_t*)(ws + OFF_Z); bf16_t* rb = (bf16_t*)(ws + OFF_R);
    const bf16_t* qtm = (const bf16_t*)(ws + OFF_Q); const bf16_t* ktm = (const bf16_t*)(ws + OFF_K); const bf16_t* vT = (const bf16_t*)(ws + OFF_VT);
    const bf16_t* sst = (const bf16_t*)p.out;
    const bf16_t* gst = (const bf16_t*)((const unsigned char*)p.out + OUT_HALF);
    constexpr int U1 = 512, U2 = 1024;
    for (int u = 2 * blockIdx.x + VB; u < U1 + U2; u += 2 * gridDim.x) {
        int tid = VTID;
        asm volatile("" : "+v"(tid));
        const int lane = tid & 63, w = __builtin_amdgcn_readfirstlane(tid >> 6), lr = lane & 31, lh = lane >> 5;
#ifndef NO_SSD
        if (u < U1) {
            const int hq = u & 1, g = (u >> 1) & 1, cc = u >> 2, t0 = cc * 128;
            __syncthreads();
            for (int i = tid; i < 1024; i += NTHREADS) {
                const int tok = i >> 3, hh = i & 7;
                lds[i] = dac[(size_t)(t0 + tok) * 16 + g * 8 + hh];
                lds[1024 + i] = dtp[(size_t)(t0 + tok) * 16 + g * 8 + hh];
            }
            __syncthreads();
            const bf16_t* cp = ctm + (size_t)(t0 + w * 32 + lr) * 256 + g * 128 + 8 * lh;
            bf16x8 cf[8];
#pragma unroll
            for (int ks = 0; ks < 8; ++ks) cf[ks] = ld_frag(cp + ks * 16);
            float ssq_acc[16];
#pragma unroll
            for (int r = 0; r < 16; ++r) ssq_acc[r] = 0.f;
#pragma unroll 1
            for (int hh = hq * 4; hh < hq * 4 + 4; ++hh) {
                const int h = g * 8 + hh;
                f32x16 acc[2] = {zero16(), zero16()};
                const bf16_t* hent = sst + (size_t)(cc * 16 + h) * 64 * 128;
#pragma unroll
                for (int ks = 0; ks < 8; ++ks) {
#pragma unroll
                    for (int ni = 0; ni < 2; ++ni)
                        acc[ni] = MFMA(cf[ks], ld_frag(hent + sidx2(ni * 32 + lr, ks * 16 + 8 * lh)), acc[ni]);
                }
#pragma unroll
                for (int r = 0; r < 16; ++r) {
                    const float e = __expf(lds[(w * 32 + crow(r, lh)) * 8 + hh]);
                    acc[0][r] *= e; acc[1][r] *= e;
                }
                const float dAi = lds[(w * 32 + lr) * 8 + hh];
#pragma unroll 1
                for (int jt = 0; jt <= w; ++jt) {
                    const bf16_t* bp = btm + (size_t)(t0 + jt * 32 + lr) * 256 + g * 128 + 8 * lh;
                    bf16x8 bfr[8];
#pragma unroll
                    for (int ks = 0; ks < 8; ++ks) bfr[ks] = ld_frag(bp + ks * 16);
                    bf16x8 xf[2][2];
#pragma unroll
                    for (int s = 0; s < 2; ++s)
#pragma unroll
                        for (int ni = 0; ni < 2; ++ni) {
                            const int xch = h * 64 + ni * 32 + lr, xt = t0 + jt * 32 + 16 * s;
                            xf[s][ni] = ld_frag2(xT + tidx(xch, xt) + 4 * lh, xT + tidx(xch, xt + 8) + 4 * lh);
                        }
                    f32x16 ST = zero16();
#pragma unroll
                    for (int ks = 0; ks < 8; ++ks) ST = MFMA(bfr[ks], cf[ks], ST);
#pragma unroll
                    for (int r = 0; r < 16; ++r) {
                        const int jl = crow(r, lh), j = jt * 32 + jl;
                        const float v = ST[r] * __expf(dAi - lds[j * 8 + hh]) * lds[1024 + j * 8 + hh];
                        ST[r] = (jt < w || jl <= lr) ? v : 0.f;
                    }
#pragma unroll
                    for (int s = 0; s < 2; ++s) {
                        const bf16x8 af = pack_step(ST, s);
#pragma unroll
                        for (int ni = 0; ni < 2; ++ni) acc[ni] = MFMA(af, xf[s][ni], acc[ni]);
                    }
                }
                __builtin_amdgcn_sched_barrier(0);
                const float Dh = p.in[6][h];
#pragma unroll
                for (int ni = 0; ni < 2; ++ni) {
                    __builtin_amdgcn_sched_barrier(0);
                    const int ch = h * 64 + ni * 32 + lr;
                    const float gn = p.in[7][ch];
#pragma unroll
                    for (int rg = 0; rg < 4; ++rg) {
                        const int tb = t0 + w * 32 + 8 * rg + 4 * lh;
                        const u32x2 xv = *(const u32x2*)(xT + tidx(ch, tb));
                        const float xs[4] = {bflo(xv.x), bfhi(xv.x), bflo(xv.y), bfhi(xv.y)};
#pragma unroll
                        for (int e = 0; e < 4; ++e) {
                            const int r = 4 * rg + e;
                            const size_t zi = (size_t)(tb + e) * 1024 + ch;
                            float y = acc[ni][r] + Dh * xs[e];
                            y *= siluf_(bf2f(zb[zi]));
                            ssq_acc[r] += y * y;
                            zb[zi] = f2bf(y * gn);
                        }
                    }
                }
            }
#pragma unroll
            for (int r = 0; r < 16; ++r) {
                const float v = half_reduce(ssq_acc[r]);
                if (lr == 0) atomicAdd(ssq + t0 + w * 32 + crow(r, lh), v);
            }
        }
#endif
#ifndef NO_GLA
        if (u >= U1) {
            const int uu = u - U1, half = (uu ^ (uu >> 9)) & 1, hd = (uu >> 1) & 3, cc = uu >> 3, t0 = cc * 128;
            const int rt = 2 * half + (w >> 1), vh = w & 1;
            bf16x8 qf[8];
#pragma unroll
            for (int ks = 0; ks < 8; ++ks) qf[ks] = ld_frag(qtm + (size_t)(t0 + rt * 32 + lr) * 512 + hd * 128 + ks * 16 + 8 * lh);
            f32x16 o[4] = {zero16(), zero16(), zero16(), zero16()};
            const bf16_t* sent = gst + (size_t)(cc * 4 + hd) * 256 * 128;
#pragma unroll
            for (int ks = 0; ks < 8; ++ks)
#pragma unroll
                for (int ni = 0; ni < 4; ++ni)
                    o[ni] = MFMA(qf[ks], ld_frag(sent + sidx2(vh * 128 + ni * 32 + lr, ks * 16 + 8 * lh)), o[ni]);
#pragma unroll 1
            for (int jt = 0; jt <= rt; ++jt) {
                f32x16 ST = zero16();
                const bf16_t* kp = ktm + (size_t)(t0 + jt * 32 + lr) * 512 + hd * 128 + 8 * lh;
#pragma unroll
                for (int ks = 0; ks < 8; ++ks) ST = MFMA(ld_frag(kp + ks * 16), qf[ks], ST);
                if (jt == rt) {
#pragma unroll
                    for (int r = 0; r < 16; ++r) ST[r] = (crow(r, lh) <= lr) ? ST[r] : 0.f;
                }
#pragma unroll
                for (int s = 0; s < 2; ++s) {
                    const bf16x8 af = pack_step(ST, s);
#pragma unroll
                    for (int ni = 0; ni < 4; ++ni) {
                        const int vch = hd * 256 + vh * 128 + ni * 32 + lr, vt = t0 + jt * 32 + 16 * s;
                        o[ni] = MFMA(af, ld_frag2(vT + tidx(vch, vt) + 4 * lh, vT + tidx(vch, vt + 8) + 4 * lh), o[ni]);
                    }
                }
            }
            float ss[16];
#pragma unroll
            for (int r = 0; r < 16; ++r) {
                float v = 0.f;
#pragma unroll
                for (int ni = 0; ni < 4; ++ni) v += o[ni][r] * o[ni][r];
                ss[r] = half_reduce(v);
            }
            __syncthreads();
            if (lr == 0) {
#pragma unroll
                for (int r = 0; r < 16; ++r) lds[w * 32 + lh * 16 + r] = ss[r];
            }
            __syncthreads();
#pragma unroll
            for (int r = 0; r < 16; ++r) ss[r] = rsqrtf((ss[r] + lds[(w ^ 1) * 32 + lh * 16 + r]) * (1.f / 256.f) + LN_EPS);
            const int par = lr & 1;
#pragma unroll
            for (int ni = 0; ni < 4; ++ni) {
                const int ch = hd * 256 + vh * 128 + ni * 32 + lr;
                const float gn = p.in[10][ch];
#pragma unroll
                for (int k = 0; k < 8; ++k) {
                    const float pre0 = o[ni][2 * k] * ss[2 * k] * gn, pre1 = o[ni][2 * k + 1] * ss[2 * k + 1] * gn;
                    const float recv = __shfl_xor(par ? pre0 : pre1, 1);
                    const float lo = par ? recv : pre0, hi = par ? pre1 : recv;
                    unsigned* gp = (unsigned*)(rb + (size_t)(t0 + rt * 32 + crow(2 * k, lh) + par) * 1024 + (ch & ~1));
                    const unsigned u = *gp;
                    *gp = pack2(lo * siluf_(bflo(u)), hi * siluf_(bfhi(u)));
                }
            }
        }
#endif
    }
}

DI void phase_ln(const float* src, float* dst, bf16_t* dstb, const float* g, const float* b) {
    const int T_ = opaque_tid();
    const int lane = T_ & 63, w = T_ >> 6;
    for (int r8 = blockIdx.x; r8 < M_ / 8; r8 += gridDim.x) {
        const int row = r8 * 8 + w;
        const float* s = src + (size_t)row * 1024;
        f32x4 v[4];
        float sum = 0.f;
#pragma unroll
        for (int i = 0; i < 4; ++i) { v[i] = *(const f32x4*)(s + i * 256 + lane * 4); sum += v[i][0] + v[i][1] + v[i][2] + v[i][3]; }
        sum = half_reduce(sum); sum += __shfl_xor(sum, 32);
        const float mu = sum * (1.f / 1024.f);
        float sq = 0.f;
#pragma unroll
        for (int i = 0; i < 4; ++i)
#pragma unroll
            for (int e = 0; e < 4; ++e) { const float d = v[i][e] - mu; sq += d * d; }
        sq = half_reduce(sq); sq += __shfl_xor(sq, 32);
        const float rs = rsqrtf(sq * (1.f / 1024.f) + LN_EPS);
#pragma unroll
        for (int i = 0; i < 4; ++i) {
            const int c = i * 256 + lane * 4;
            const f32x4 gv = *(const f32x4*)(g + c), bv = *(const f32x4*)(b + c);
            f32x4 o;
#pragma unroll
            for (int e = 0; e < 4; ++e) o[e] = (v[i][e] - mu) * rs * gv[e] + bv[e];
            *(f32x4*)(dst + (size_t)row * 1024 + c) = o;
            if (dstb) { u32x2 pk; pk.x = pack2(o[0], o[1]); pk.y = pack2(o[2], o[3]); *(u32x2*)(dstb + (size_t)row * 1024 + c) = pk; }
        }
    }
}

struct S5Lane { float abr[2], abi[2]; bf16x8 bfrag[4]; };
DI void s5_setup(const unsigned char* ws, int g, int lr, int lh, S5Lane& L) {
    const float* ab = (const float*)(ws + OFF_S5AB);
#pragma unroll
    for (int q = 0; q < 2; ++q) { L.abr[q] = ab[(g * 64 + 32 * q + lr) * 2]; L.abi[q] = ab[(g * 64 + 32 * q + lr) * 2 + 1]; }
#pragma unroll
    for (int nt = 0; nt < 4; ++nt) L.bfrag[nt] = ld_frag((const bf16_t*)(ws + OFF_S5BB) + ((((size_t)g * 4 + nt) * 2 + lh) * 32 + lr) * 8);
}
DI int s5_row_token(int pr, int tile, int r) { return (2 * pr + ((r >> 2) & 1)) * S5CH + tile * 16 + 4 * (r >> 3) + (r & 3); }

DI void phase_s5_local(const Params& p) {
    const int T_ = opaque_tid();
    unsigned char* ws = p.ws;
    const int tid = T_, lane = tid & 63, w = tid >> 6, lr = lane & 31, lh = lane >> 5;
    const bf16_t* xb = (const bf16_t*)p.out;
    float* sloc = (float*)(ws + OFF_SLOC);
    for (int bu = blockIdx.x; bu < (S5NCH / 2) * 64 / 8; bu += gridDim.x) {
        const int wu = bu * 8 + w, g = wu & 63, pr = wu >> 6;
        S5Lane L; s5_setup(ws, g, lr, lh, L);
        float cr[2] = {0.f, 0.f}, ci[2] = {0.f, 0.f};
#pragma unroll 2
        for (int tile = 0; tile < S5CH / 16; ++tile) {
            const bf16x8 a = ld_frag(xb + (size_t)s5_row_token(pr, tile, lr) * 1024 + g * 16 + 8 * lh);
            f32x16 buv[4];
#pragma unroll
            for (int nt = 0; nt < 4; ++nt) buv[nt] = MFMA(a, L.bfrag[nt], zero16());
#pragma unroll
            for (int q = 0; q < 2; ++q) {
                const float ar = L.abr[q], ai = L.abi[q];
                float sr = cr[q], si = ci[q];
#pragma unroll
                for (int i = 0; i < 16; ++i) { const float nr = ar * sr - ai * si + buv[2 * q][i], ni = ar * si + ai * sr + buv[2 * q + 1][i]; sr = nr; si = ni; }
                cr[q] = sr; ci[q] = si;
            }
        }
        const int ck = 2 * pr + lh;
#pragma unroll
        for (int q = 0; q < 2; ++q) { float* d = sloc + ((size_t)(ck * 64 + g) * 64 + 32 * q + lr) * 2; d[0] = cr[q]; d[1] = ci[q]; }
    }
}
DI void phase_s5_carry(const Params& p) {
    const int T_ = opaque_tid();
    unsigned char* ws = p.ws;
    const float* sloc = (const float*)(ws + OFF_SLOC); float* sent = (float*)(ws + OFF_SENT);
    for (int e = blockIdx.x * NT + T_; e < 8192; e += gridDim.x * NT) {
        const int pp = e & 63, g = (e >> 6) & 63, b = e >> 12;
        const float step = __expf(p.in[21][g]);
        const float ar = p.in[19][g * 64 + pp], ai = p.in[20][g * 64 + pp];
        const float mag = expf(ar * step);
        float sn, cs; sincosf(ai * step, &sn, &cs);
        float tr = mag * cs, ti = mag * sn;
        for (int i = 0; i < 7; ++i) { const float nr = tr * tr - ti * ti, ni = 2.f * tr * ti; tr = nr; ti = ni; }
        static_assert(S5CH == 128, "squaring count");
        float sr = 0.f, si = 0.f;
        typedef float f32x2_ __attribute__((ext_vector_type(2)));
        const f32x2_* __restrict__ sl2 = (const f32x2_*)sloc;
        f32x2_* __restrict__ se2 = (f32x2_*)sent;
#pragma unroll 1
        for (int kb = 0; kb < S5CPB; kb += 16) {
            f32x2_ lv[16];
#pragma unroll
            for (int i = 0; i < 16; ++i) lv[i] = sl2[(size_t)((b * S5CPB + kb + i) * 64 + g) * 64 + pp];
#pragma unroll
            for (int i = 0; i < 16; ++i) {
                f32x2_ o; o.x = sr; o.y = si;
                se2[(size_t)((b * S5CPB + kb + i) * 64 + g) * 64 + pp] = o;
                const float nr = tr * sr - ti * si + lv[i].x, ni = tr * si + ti * sr + lv[i].y;
                sr = nr; si = ni;
            }
        }
    }
}
DI void phase_s5_out(const Params& p, unsigned char* smem) {
    const int T_ = opaque_tid();
    unsigned char* ws = p.ws;
    const int tid = T_, lane = tid & 63, w = tid >> 6, lr = lane & 31, lh = lane >> 5;
    const bf16_t* xb = (const bf16_t*)p.out;
    bf16_t* yb = (bf16_t*)((unsigned char*)p.out + OUT_HALF);
    const float* xf = (const float*)(ws + OFF_U);
    const float* sent = (const float*)(ws + OFF_SENT);
    constexpr int SROW = 136;
    bf16_t* sl = (bf16_t*)smem + w * 32 * SROW;
    unsigned* sl32 = (unsigned*)sl;
    for (int bu = blockIdx.x; bu < (S5NCH / 2) * 64 / 8; bu += gridDim.x) {
        const int wu = bu * 8 + w, g = wu & 63, pr = wu >> 6;
        S5Lane L; s5_setup(ws, g, lr, lh, L);
        bf16x8 cfr[4];
#pragma unroll
        for (int ks = 0; ks < 4; ++ks) cfr[ks] = ld_frag((const bf16_t*)(ws + OFF_S5CM) + (((size_t)g * 4 + ks) * 64 + lane) * 8);
        const int ck = 2 * pr + lh;
        float cr[2], ci[2];
#pragma unroll
        for (int q = 0; q < 2; ++q) { const float* s0 = sent + ((size_t)(ck * 64 + g) * 64 + 32 * q + lr) * 2; cr[q] = s0[0]; ci[q] = s0[1]; }
        const int ch = g * 16 + (lane & 15);
        const float Dv = p.in[26][ch];
        bf16x8 a_nxt = ld_frag(xb + (size_t)s5_row_token(pr, 0, lr) * 1024 + g * 16 + 8 * lh);
#pragma unroll 1
        for (int tile = 0; tile < S5CH / 16; ++tile) {
            const bf16x8 a = a_nxt;
            if (tile + 1 < S5CH / 16) a_nxt = ld_frag(xb + (size_t)s5_row_token(pr, tile + 1, lr) * 1024 + g * 16 + 8 * lh);
            f32x16 buv[4];
#pragma unroll
            for (int nt = 0; nt < 4; ++nt) buv[nt] = MFMA(a, L.bfrag[nt], zero16());
            asm volatile("s_waitcnt lgkmcnt(0)" ::: "memory");
#pragma unroll
            for (int q = 0; q < 2; ++q) {
                const float ar = L.abr[q], ai = L.abi[q];
                float sr = cr[q], si = ci[q];
#pragma unroll
                for (int i = 0; i < 16; ++i) {
                    const float nr = ar * sr - ai * si + buv[2 * q][i], ni = ar * si + ai * sr + buv[2 * q + 1][i]; sr = nr; si = ni;
                    sl32[(16 * lh + i) * (SROW / 2) + 32 * q + lr] = pack2(sr, si);
                }
                cr[q] = sr; ci[q] = si;
            }
            asm volatile("s_waitcnt lgkmcnt(0)" ::: "memory");
#pragma unroll
            for (int t16 = 0; t16 < 2; ++t16) {
                f32x4 y = {0.f, 0.f, 0.f, 0.f};
#pragma unroll
                for (int ks = 0; ks < 4; ++ks)
                    y = __builtin_amdgcn_mfma_f32_16x16x32_bf16(ld_frag(sl + (t16 * 16 + (lane & 15)) * SROW + ks * 32 + 8 * (lane >> 4)), cfr[ks], y, 0, 0, 0);
#pragma unroll
                for (int r = 0; r < 4; ++r) {
                    const size_t idx = (size_t)((2 * pr + t16) * S5CH + tile * 16 + (lane >> 4) * 4 + r) * 1024 + ch;
                    yb[idx] = f2bf(gelu_tanh(y[r] + Dv * xf[idx]));
                }
            }
        }
    }
}

#define XB_TMO      128
#define XB_XCNT(j)  (256  + 64 * (j))
#define XB_XSUB(j)  (1280 + 64 * (j))
#define XB_XGEN(j)  (2304 + 64 * (j))
#define XB_TOP      3328
#define XB_TOPGEN   3392
#define XCD_BAR_WORDS 3456
#define XB_SPIN_CAP (1u << 18)
#define LAS __attribute__((address_space(3)))

__device__ __forceinline__ unsigned xb_ld(unsigned* p)              { return __hip_atomic_load(p, __ATOMIC_RELAXED, __HIP_MEMORY_SCOPE_AGENT); }
__device__ __forceinline__ unsigned xb_add(unsigned* p, unsigned v) { return __hip_atomic_fetch_add(p, v, __ATOMIC_RELAXED, __HIP_MEMORY_SCOPE_AGENT); }
__device__ __forceinline__ unsigned xb_xcc_id() { return (unsigned)__builtin_amdgcn_s_getreg((3 << 11) | 20) & 0xFu; }
#define XB_SPIN(cond, bar) do { unsigned _sp = 0; while (cond) { __builtin_amdgcn_s_sleep(1); \
    if ((++_sp & 255u) == 0u) { if (xb_ld(&(bar)[XB_TMO])) break; if (_sp > XB_SPIN_CAP) { atomicAdd(&(bar)[XB_TMO], 1u); break; } } } } while (0)

struct XcdBarrier {
    unsigned* bar; unsigned x;
    volatile LAS unsigned* st;
};

__device__ __forceinline__ XcdBarrier xcd_barrier_post(unsigned* bar, volatile LAS unsigned* st) {
    XcdBarrier b; b.bar = bar; b.x = xb_xcc_id(); b.st = st;
    if (threadIdx.x == 0) (void)xb_add(&bar[XB_XCNT(b.x)], 1u);
    return b;
}
__device__ __forceinline__ void xcd_barrier_complete(unsigned* bar, unsigned x, unsigned& nloc, unsigned& nx) {
    const unsigned G = gridDim.x * gridDim.y * gridDim.z;
    unsigned sum, cnt, mine, sp = 0u;
    for (;;) {
        sum = 0u; cnt = 0u; mine = 0u;
#pragma unroll
        for (unsigned j = 0; j < 16; ++j) { const unsigned c = xb_ld(&bar[XB_XCNT(j)]); sum += c; cnt += (c > 0u) ? 1u : 0u; mine = (j == x) ? c : mine; }
        if (sum == G) break;
        __builtin_amdgcn_s_sleep(1);
        if ((++sp & 255u) == 0u) { if (xb_ld(&bar[XB_TMO])) break; if (sp > XB_SPIN_CAP) { atomicAdd(&bar[XB_TMO], 1u); break; } }
    }
    nloc = mine > 0u ? mine : 1u; nx = cnt > 0u ? cnt : 1u;
}

__device__ __forceinline__ void xcd_barrier(const XcdBarrier& b) {
    asm volatile("s_waitcnt vmcnt(0)" ::: "memory");
    __syncthreads();
    if (threadIdx.x == 0) {
        unsigned* bar = b.bar;
        unsigned bx_ = b.x;
        asm volatile("" : "+s"(bx_));
        __builtin_amdgcn_s_waitcnt(0);
        unsigned nloc = b.st[0], nx = b.st[1];
        if (nloc == 0u) { xcd_barrier_complete(bar, bx_, nloc, nx); b.st[0] = nloc; b.st[1] = nx; }
        const unsigned old = xb_add(&bar[XB_XSUB(bx_)], 1u);
        const unsigned gen = old / nloc;
        if (old + 1u == (gen + 1u) * nloc) {
            __builtin_amdgcn_fence(__ATOMIC_RELEASE, "agent");
            asm volatile("s_waitcnt vmcnt(0)" ::: "memory");
            const unsigned og = xb_add(&bar[XB_TOP], 1u);
            const unsigned tg = og / nx;
            if (og + 1u == (tg + 1u) * nx) xb_add(&bar[XB_TOPGEN], 1u);
            else XB_SPIN(xb_ld(&bar[XB_TOPGEN]) == tg, bar);
            __builtin_amdgcn_fence(__ATOMIC_ACQUIRE, "agent");
            xb_add(&bar[XB_XGEN(bx_)], 1u);
            asm volatile("s_waitcnt vmcnt(0)" ::: "memory");
        } else {
            XB_SPIN(xb_ld(&bar[XB_XGEN(bx_)]) == gen, bar);
            __builtin_amdgcn_fence(__ATOMIC_ACQUIRE, "agent");
            asm volatile("s_waitcnt vmcnt(0)" ::: "memory");
        }
    }
    __syncthreads();
}


constexpr int NPHASE = 19;
#ifdef ONLY_PHASE
#define PEN(n) ((n) == ONLY_PHASE)
#else
#define PEN(n) true
#endif
__global__ void __launch_bounds__(NT) mega(Params p) {
    __builtin_assume(__builtin_amdgcn_workitem_id_y() == 0);
    __builtin_assume(__builtin_amdgcn_workitem_id_z() == 0);
    extern __shared__ __attribute__((aligned(16))) unsigned char smem[];
    cg::grid_group grid = cg::this_grid();
    unsigned char* ws = p.ws;
    float* U = (float*)(ws + OFF_U);
    bf16_t* xb = (bf16_t*)p.out;
    bf16_t* yb = (bf16_t*)((unsigned char*)p.out + OUT_HALF);
    bf16_t* hmid = (bf16_t*)(ws + OFF_HMID);
    bf16_t* shm = (bf16_t*)smem;
    volatile LAS unsigned* xst = (volatile LAS unsigned*)(smem + g8::SHM_B);
    if (threadIdx.x < 2) xst[threadIdx.x] = 0u;
    __syncthreads();
    const XcdBarrier gbar = xcd_barrier_post((unsigned*)(ws + OFF_BAR), xst);
#ifndef DUP
#define DUP 0
#endif
#define PHASE_BEGIN(n) for (int rep_ = 0; rep_ < (((DUP) >> (n)) & 1) + 1; ++rep_) { if (PEN(n)) {
#define PHASE_END }  xcd_barrier(gbar); }
    if (PEN(0)) phase_prep0(p, smem);
    if (p.ph_hi) grid.sync();
    xcd_barrier(gbar);
    PHASE_BEGIN(1)
        EpiInProj e{(bf16_t*)(ws + OFF_Z), (bf16_t*)(ws + OFF_XT), (bf16_t*)(ws + OFF_BTM), (bf16_t*)(ws + OFF_CTM), (bf16_t*)(ws + OFF_Q), (bf16_t*)(ws + OFF_K),
                    (bf16_t*)(ws + OFF_VT), (bf16_t*)(ws + OFF_R), (bf16_t*)(ws + OFF_XHALO), (bf16_t*)(ws + OFF_BCHALO), (float*)(ws + OFF_DT), (float*)(ws + OFF_GA), p.in[4]};
        g8::phase(xb, 1024, (const bf16_t*)(ws + OFF_WT_IN), 1024, 1024, M_, NIN, shm, e);
    PHASE_END
    PHASE_BEGIN(2) phase_conv_gates(p, smem); PHASE_END
    PHASE_BEGIN(3) phase_states(p); PHASE_END
    PHASE_BEGIN(4) phase_carry(p); PHASE_END
    PHASE_BEGIN(5) phase_mixer_out(p, smem); PHASE_END
    PHASE_BEGIN(6)
        EpiResidual<0> e0{U, p.in[0], nullptr};
        g8::phase((const bf16_t*)(ws + OFF_R), 1024, (const bf16_t*)(ws + OFF_WT_OUT) + 1024, 2048, 1024, M_, 1024, shm, e0);
        EpiResidual<1> e1{U, nullptr, (const float*)(ws + OFF_SSQ)};
        g8::phase((const bf16_t*)(ws + OFF_Z), 1024, (const bf16_t*)(ws + OFF_WT_OUT), 2048, 1024, M_, 1024, shm, e1);
    PHASE_END
    PHASE_BEGIN(7) phase_ln(U, U, xb, p.in[12], p.in[13]); PHASE_END
    PHASE_BEGIN(8) EpiSwiGLU e{hmid}; g8::phase(xb, 1024, (const bf16_t*)(ws + OFF_WT_GU0), 1024, 1024, M_, 5632, shm, e);
        __syncthreads();
        prep_w1(p, smem, (int)gridDim.x == 256 ? 128 : 0);
    PHASE_END
    PHASE_BEGIN(9) EpiResidual<0> e{U, U, nullptr}; g8::phase(hmid, FFH, (const bf16_t*)(ws + OFF_WT_DN0), FFH, FFH, M_, 1024, shm, e); PHASE_END
    PHASE_BEGIN(10) phase_ln(U, U, xb, p.in[17], p.in[18]); PHASE_END
    PHASE_BEGIN(11) phase_s5_local(p); PHASE_END
    PHASE_BEGIN(12) phase_s5_carry(p); PHASE_END
    PHASE_BEGIN(13) phase_s5_out(p, smem); PHASE_END
    PHASE_BEGIN(14) EpiGLU e{U, p.in[28], p.in[30]}; g8::phase(yb, 1024, (const bf16_t*)(ws + OFF_WT_GLU), 1024, 1024, M_, 2048, shm, e); PHASE_END
    PHASE_BEGIN(15) phase_ln(U, U, xb, p.in[31], p.in[32]); PHASE_END
    PHASE_BEGIN(16) EpiSwiGLU e{hmid}; g8::phase(xb, 1024, (const bf16_t*)(ws + OFF_WT_GU1), 1024, 1024, M_, 5632, shm, e); PHASE_END
    PHASE_BEGIN(17) EpiResidual<0> e{U, U, nullptr}; g8::phase(hmid, FFH, (const bf16_t*)(ws + OFF_WT_DN1), FFH, FFH, M_, 1024, shm, e); PHASE_END
    if (PEN(18)) phase_ln(U, p.out, nullptr, p.in[36], p.in[37]);
}

extern "C" void kernel_launch(void* const* d_in, const int* in_sizes, int n_in, void* d_out, int out_size, void* d_ws, size_t ws_size, hipStream_t stream) {
    static int grid_blocks = 0;
    constexpr size_t kDynLds = g8::SHM_B + 16;
    if (grid_blocks == 0) {
        if (n_in != 38 || out_size != M_ * D_ || ws_size < WS_TOTAL) { fprintf(stderr, "kernel_launch: unexpected shapes (n_in %d out %d ws %zu need %zu)\n", n_in, out_size, ws_size, (size_t)WS_TOTAL); grid_blocks = -1; return; }
        int dev = 0, cus = 0, per_cu = 0;
        (void)hipGetDevice(&dev);
        (void)hipDeviceGetAttribute(&cus, hipDeviceAttributeMultiprocessorCount, dev);
        if (hipFuncSetAttribute((const void*)mega, hipFuncAttributeMaxDynamicSharedMemorySize, (int)kDynLds) != hipSuccess) { fprintf(stderr, "hipFuncSetAttribute failed\n"); (void)hipGetLastError(); }
        if (hipOccupancyMaxActiveBlocksPerMultiprocessor(&per_cu, (const void*)mega, NT, kDynLds) != hipSuccess || per_cu < 1) { fprintf(stderr, "occupancy query failed (%d)\n", per_cu); (void)hipGetLastError(); per_cu = 1; }
        grid_blocks = cus;
        (void)per_cu;
    }
    if (grid_blocks < 0) return;
    if (hipMemsetAsync((unsigned char*)d_ws + OFF_BAR, 0, 3456 * 4, stream) != hipSuccess) { fprintf(stderr, "barrier memset failed\n"); return; }
    Params p{};
    for (int i = 0; i < 38; ++i) p.in[i] = (const float*)d_in[i];
    p.out = (float*)d_out; p.ws = (unsigned char*)d_ws; p.ph_lo = 0; p.ph_hi = 0;
    void* args[] = {&p};
    hipError_t e = hipLaunchCooperativeKernel((const void*)mega, dim3(grid_blocks), dim3(NT), args, kDynLds, stream);
    if (e != hipSuccess) fprintf(stderr, "cooperative launch failed: %s (grid %d)\n", hipGetErrorString(e), grid_blocks);
}
```
